# Optimizing an MI355X kernel written in HIP

```python
import jax
import jax.numpy as jnp
from jax import lax
import numpy as np

D_MODEL = 1024
BATCH = 16
SEQ = 2048
DEPTH = 2

D_MIX = D_MODEL
MLSTM_HEADS = 4
MLSTM_DQK = D_MODEL // 8
MLSTM_DV = D_MODEL // 8
MLSTM_WIDTH = MLSTM_HEADS * MLSTM_DV
CONV_WIDTH = D_MIX - MLSTM_WIDTH
CONV_K = 3
CHUNK = 64
N_GROUPS = 4
EXPERTS_PER_GROUP = 4
TOP_K = 2
D_EXPERT = D_MODEL // 2
ALPHA = (2 * DEPTH) ** 0.25
BETA = (8 * DEPTH) ** -0.25
LN_EPS = 1e-5
IN_SIZES = (MLSTM_HEADS * MLSTM_DQK, MLSTM_HEADS * MLSTM_DQK, MLSTM_WIDTH, MLSTM_WIDTH,
            MLSTM_HEADS, MLSTM_HEADS, CONV_WIDTH, CONV_WIDTH, CONV_WIDTH)
D_IN = sum(IN_SIZES)

kernel_name = 'hybrid_mlstm_shortconv_hiermoe_deepnorm_adaln'


def layer_norm(x, g, b):
    xf = x.astype(jnp.float32)
    mu = xf.mean(-1, keepdims=True)
    var = jnp.square(xf - mu).mean(-1, keepdims=True)
    y = (xf - mu) * lax.rsqrt(var + LN_EPS) * g.astype(jnp.float32) + b.astype(jnp.float32)
    return y.astype(x.dtype)


def head_norm(h, w):
    bsz, seq, nh, dv = h.shape
    mu = h.mean(-1, keepdims=True)
    var = jnp.square(h - mu).mean(-1, keepdims=True)
    hn = (h - mu) * lax.rsqrt(var + LN_EPS)
    return hn.reshape(bsz, seq, nh * dv) * w.astype(jnp.float32)


def mlstm_chunkwise(q, k, v, i_pre, f_pre):
    f32 = jnp.float32
    bsz, seq, nh, dk = q.shape
    dv = v.shape[-1]
    nc = seq // CHUNK

    def to_chunks(t):
        t = t.astype(f32).reshape((bsz, nc, CHUNK, nh) + t.shape[3:])
        return jnp.moveaxis(t, 3, 1)

    qc = to_chunks(q) * (dk ** -0.5)
    kc = to_chunks(k)
    vc = to_chunks(v)
    ig = to_chunks(i_pre)
    logf = jax.nn.log_sigmoid(to_chunks(f_pre))
    bcum = jnp.cumsum(logf, axis=-1)
    gtot = bcum[..., -1]

    causal = jnp.tril(jnp.ones((CHUNK, CHUNK), dtype=bool))
    dmat = jnp.where(causal, bcum[..., :, None] - bcum[..., None, :] + ig[..., None, :], -jnp.inf)

    a = gtot[..., None] - bcum + ig
    m_loc = a.max(-1)
    w_loc = jnp.exp(a - m_loc[..., None])
    c_loc = jnp.einsum('bhcsv,bhcsk->bhcvk', w_loc[..., None] * vc, kc)
    n_loc = jnp.einsum('bhcs,bhcsk->bhck', w_loc, kc)

    def step(carry, xs):
        c_st, n_st, m_st = carry
        g_c, m_c, cl, nl = xs
        m_new = jnp.maximum(g_c + m_st, m_c)
        decay = jnp.exp(g_c + m_st - m_new)
        inj = jnp.exp(m_c - m_new)
        c_new = decay[..., None, None] * c_st + inj[..., None, None] * cl
        n_new = decay[..., None] * n_st + inj[..., None] * nl
        return (c_new, n_new, m_new), (c_st, n_st, m_st)

    init = (jnp.zeros((bsz, nh, dv, dk), f32), jnp.zeros((bsz, nh, dk), f32),
            jnp.zeros((bsz, nh), f32))
    xs = (jnp.moveaxis(gtot, 2, 0), jnp.moveaxis(m_loc, 2, 0),
          jnp.moveaxis(c_loc, 2, 0), jnp.moveaxis(n_loc, 2, 0))
    _, (c_prev, n_prev, m_prev) = lax.scan(step, init, xs)
    c_prev = jnp.moveaxis(c_prev, 0, 2)
    n_prev = jnp.moveaxis(n_prev, 0, 2)
    m_prev = jnp.moveaxis(m_prev, 0, 2)

    e_inter = bcum + m_prev[..., None]
    m_t = jnp.maximum(e_inter, dmat.max(-1))
    s_mat = jnp.einsum('bhctk,bhcsk->bhcts', qc, kc) * jnp.exp(dmat - m_t[..., None])
    w_inter = jnp.exp(e_inter - m_t)
    num = (jnp.einsum('bhcts,bhcsv->bhctv', s_mat, vc)
           + w_inter[..., None] * jnp.einsum('bhcvk,bhctk->bhctv', c_prev, qc))
    den = s_mat.sum(-1) + w_inter * jnp.einsum('bhck,bhctk->bhct', n_prev, qc)
    h = num / jnp.maximum(jnp.abs(den), jnp.exp(-m_t))[..., None]
    return jnp.moveaxis(h, 1, 3).reshape(bsz, seq, nh, dv)


def short_gated_conv(b_gate, c_gate, h_in, w_conv):
    z = c_gate * h_in
    zc = lax.conv_general_dilated(z, w_conv[:, None, :], window_strides=(1,),
                                  padding=[(CONV_K - 1, 0)],
                                  dimension_numbers=('NWC', 'WIO', 'NWC'),
                                  feature_group_count=z.shape[-1])
    return b_gate * zc


def hier_moe(u, w_grp, b_grp, w_router, b_router, w_gate, w_up, w_down):
    f32 = jnp.float32
    bsz, seq, dm = u.shape
    t = u.reshape(bsz * seq, dm)
    grp_logits = (t @ w_grp + b_grp).astype(f32)
    grp_prob = jax.nn.softmax(grp_logits, axis=-1)
    grp_idx = jnp.argmax(grp_logits, axis=-1)
    grp_w = jnp.take_along_axis(grp_prob, grp_idx[:, None], axis=-1)
    exp_logits = (t @ w_router + b_router).astype(f32).reshape(-1, N_GROUPS, EXPERTS_PER_GROUP)
    sel_logits = jnp.take_along_axis(exp_logits, grp_idx[:, None, None], axis=1)[:, 0]
    top_vals, top_idx = lax.top_k(sel_logits, TOP_K)
    top_w = jax.nn.softmax(top_vals, axis=-1) * grp_w
    exp_w = jnp.einsum('tk,tke->te', top_w, jax.nn.one_hot(top_idx, EXPERTS_PER_GROUP, dtype=f32))
    comb = (jax.nn.one_hot(grp_idx, N_GROUPS, dtype=f32)[:, :, None] * exp_w[:, None, :]).astype(u.dtype)
    y = jnp.zeros_like(t)
    for gi in range(N_GROUPS):
        hg = (jax.nn.silu(jnp.einsum('td,edf->tef', t, w_gate[gi]))
              * jnp.einsum('td,edf->tef', t, w_up[gi]))
        y = y + jnp.einsum('tef,efd->td', hg * comb[:, gi, :, None], w_down[gi])
    return y.reshape(bsz, seq, dm)


def setup_inputs(seed: int = 0) -> dict:
    key = jax.random.key(seed)
    ks = jax.random.split(key, 24)
    nrm = jax.random.normal
    H = MLSTM_HEADS
    G, E, F = N_GROUPS, EXPERTS_PER_GROUP, D_EXPERT
    x = nrm(ks[0], (BATCH, SEQ, D_MODEL), jnp.float32)
    c = nrm(ks[1], (BATCH, D_MODEL), jnp.float32)
    w_ada = nrm(ks[2], (DEPTH, D_MODEL, 6 * D_MODEL)) * (0.2 * D_MODEL ** -0.5)
    b_ada = 0.02 * nrm(ks[3], (DEPTH, 6 * D_MODEL))
    w_in = nrm(ks[4], (DEPTH, D_MODEL, D_IN)) * D_MODEL ** -0.5
    b_i = 0.1 * nrm(ks[5], (DEPTH, H))
    b_f = jnp.linspace(3.0, 6.0, H)[None, :] + 0.1 * nrm(ks[6], (DEPTH, H))
    b_gates = jnp.concatenate([b_i, b_f], axis=-1)
    mh_norm_w = 1.0 + 0.02 * nrm(ks[7], (DEPTH, MLSTM_WIDTH))
    w_conv = nrm(ks[8], (DEPTH, CONV_K, CONV_WIDTH)) * CONV_K ** -0.5
    w_out = nrm(ks[9], (DEPTH, D_MIX, D_MODEL)) * (BETA * D_MIX ** -0.5)
    ln1_g = 1.0 + 0.02 * nrm(ks[10], (DEPTH, D_MODEL))
    ln1_b = 0.02 * nrm(ks[11], (DEPTH, D_MODEL))
    w_grp = nrm(ks[12], (DEPTH, D_MODEL, G)) * D_MODEL ** -0.5
    b_grp = 0.01 * nrm(ks[13], (DEPTH, G))
    w_router = nrm(ks[14], (DEPTH, D_MODEL, G * E)) * D_MODEL ** -0.5
    b_router = 0.01 * nrm(ks[15], (DEPTH, G * E))
    w_gate = nrm(ks[16], (DEPTH, G, E, D_MODEL, F)) * D_MODEL ** -0.5
    w_up = nrm(ks[17], (DEPTH, G, E, D_MODEL, F)) * D_MODEL ** -0.5
    w_down = nrm(ks[18], (DEPTH, G, E, F, D_MODEL)) * (BETA * F ** -0.5)
    ln2_g = 1.0 + 0.02 * nrm(ks[19], (DEPTH, D_MODEL))
    ln2_b = 0.02 * nrm(ks[20], (DEPTH, D_MODEL))
    return {'x': x, 'c': c, 'w_ada': w_ada, 'b_ada': b_ada, 'w_in': w_in, 'b_gates': b_gates,
            'mh_norm_w': mh_norm_w, 'w_conv': w_conv, 'w_out': w_out, 'ln1_g': ln1_g,
            'ln1_b': ln1_b, 'w_grp': w_grp, 'b_grp': b_grp, 'w_router': w_router,
            'b_router': b_router, 'w_gate': w_gate, 'w_up': w_up, 'w_down': w_down,
            'ln2_g': ln2_g, 'ln2_b': ln2_b}


def reference(x, c, w_ada, b_ada, w_in, b_gates, mh_norm_w, w_conv, w_out, ln1_g, ln1_b,
              w_grp, b_grp, w_router, b_router, w_gate, w_up, w_down, ln2_g, ln2_b):
    bsz, seq, _ = x.shape
    H = MLSTM_HEADS
    split_at = np.cumsum(IN_SIZES)[:-1].tolist()
    cond = jax.nn.silu(c)
    for l in range(DEPTH):
        mod = cond @ w_ada[l] + b_ada[l]
        sh1, sc1, gt1, sh2, sc2, gt2 = [m[:, None, :] for m in jnp.split(mod, 6, axis=-1)]
        u = x * (1 + sc1) + sh1
        proj = u @ w_in[l]
        q, k, v, o, i_pre, f_pre, cb, cc, ch = jnp.split(proj, split_at, axis=-1)
        i_pre = i_pre + b_gates[l, :H]
        f_pre = f_pre + b_gates[l, H:]
        h = mlstm_chunkwise(q.reshape(bsz, seq, H, MLSTM_DQK), k.reshape(bsz, seq, H, MLSTM_DQK),
                            v.reshape(bsz, seq, H, MLSTM_DV), i_pre, f_pre)
        h = head_norm(h, mh_norm_w[l]) * jax.nn.sigmoid(o.astype(jnp.float32))
        y_conv = short_gated_conv(cb, cc, ch, w_conv[l])
        mix = jnp.concatenate([h.astype(x.dtype), y_conv], axis=-1) @ w_out[l]
        x = layer_norm(ALPHA * x + (1 + gt1) * mix, ln1_g[l], ln1_b[l])
        u = x * (1 + sc2) + sh2
        y = hier_moe(u, w_grp[l], b_grp[l], w_router[l], b_router[l], w_gate[l], w_up[l], w_down[l])
        x = layer_norm(ALPHA * x + (1 + gt2) * y, ln2_g[l], ln2_b[l])
    return x
```

```cpp
#include <hip/hip_runtime.h>
#include <cstdio>
#include <cstdint>

#define GAS __attribute__((address_space(1)))
#define LAS __attribute__((address_space(3)))
typedef unsigned short bf16;
typedef short bf16x8 __attribute__((ext_vector_type(8)));
typedef float f32x4 __attribute__((ext_vector_type(4)));
typedef float f32x2 __attribute__((ext_vector_type(2)));
typedef unsigned u32x4 __attribute__((ext_vector_type(4)));
typedef unsigned u32x2 __attribute__((ext_vector_type(2)));
typedef GAS unsigned gu32;
#define RLX_AGENT __ATOMIC_RELAXED, __HIP_MEMORY_SCOPE_AGENT
#define LDS_WAIT() asm volatile("s_waitcnt lgkmcnt(0)" ::: "memory")
#define VM_WAIT() asm volatile("s_waitcnt vmcnt(0)" ::: "memory")

constexpr int T = 32768, D = 1024, SEQ = 2048, NL = 2, DINW = 3584, DIN_SRC = 3592;
constexpr int NCLS = 24, CLS_CAP = 32768, MAXTILES = 160;
constexpr float ALPHA = 1.41421356237309505f, LN_EPS = 1e-5f, QSCALE = 0.08838834764831845f;
constexpr int NWAVES = 8, NTHR = 512;

constexpr size_t MiB = 1u << 20;
constexpr size_t WS_CTL = 0, CTL_ZERO_BYTES = 1 * MiB;
constexpr size_t WS_MOD = 1 * MiB;
constexpr size_t WS_GATES = 2 * MiB;
constexpr size_t WS_RINFO = 4 * MiB;
constexpr size_t WS_WIN = 16 * MiB;
constexpr size_t WS_WOUT = 30 * MiB;
constexpr size_t WS_WGU = 34 * MiB;
constexpr size_t WS_WD = 98 * MiB;
constexpr size_t WS_UA = 130 * MiB;
constexpr size_t WS_BIG = 194 * MiB;
constexpr size_t WS_X1 = WS_BIG + 128 * MiB;
constexpr size_t WS_Y = WS_UA;
constexpr size_t WS_END = 450 * MiB;
static_assert((size_t)(T + NCLS * 256) * 1024 * 2 <= 128 * MiB, "HID fits below X1");
constexpr int CW_TMO = 0, CW_CODE = 1, CW_CNT = 64, CW_BAR = 4096;

constexpr int RING_BYTES = 131072, MISC_OFF = RING_BYTES, LDS_BYTES = 147456;
constexpr int MO_BAR = 0, MO_TCLS = 64, MO_TTB = 1024, MO_CNT = 2048, MO_NT = 2176, MO_LCNT = 2304, MO_LBASE = 2432, MO_REC = 4096, MO_SG = 8192;

struct RInfo { int token; float wa; float wb; int pad; };

__device__ __forceinline__ unsigned f2bf(float f) { unsigned u = __builtin_bit_cast(unsigned, f); return (u + 0x7fffu + ((u >> 16) & 1u)) >> 16; }
__device__ __forceinline__ unsigned pk2(float lo, float hi) { return f2bf(lo) | (f2bf(hi) << 16); }
__device__ __forceinline__ float bf_lo(unsigned w) { return __builtin_bit_cast(float, w << 16); }
__device__ __forceinline__ float bf_hi(unsigned w) { return __builtin_bit_cast(float, w & 0xffff0000u); }
__device__ __forceinline__ float wave_sum(float v) {
#pragma unroll
    for (int o = 1; o < 64; o <<= 1) v += __shfl_xor(v, o);
    return v;
}
__device__ __forceinline__ float sigmoidf_(float x) { return 1.0f / (1.0f + __expf(-x)); }

namespace pg8 {
constexpr int BM = 256, BK = 64, HALF = 128, HTB = HALF * BK * 2, STAGE_BYTES = 8 * HTB, NXCD = 8, WGM = 8;
__host__ __device__ __forceinline__ int lds_byte(int r, int c) { const int st = (r >> 4) * 2 + (c >> 5), rr = r & 15, cc = c & 31, ob = rr * 64 + cc * 2; return st * 1024 + (ob ^ (((ob >> 9) & 1) << 5)); }
__host__ __device__ __forceinline__ void stage_rc(int b, int& R, int& C) { const int st = b / 1024, sb = b % 1024, swz = sb ^ (((sb >> 9) & 1) << 5); R = (st >> 1) * 16 + swz / 64; C = (st & 1) * 32 + (swz % 64) / 2; }
__host__ __device__ __forceinline__ int perm32(int rho) { const int n = rho >> 4, i = rho & 15; return 8 * (i >> 2) + 4 * n + (i & 3); }
__device__ __forceinline__ unsigned cvt_pk_bf16(float lo, float hi) { unsigned r; asm volatile("v_cvt_pk_bf16_f32 %0, %1, %2" : "=v"(r) : "v"(lo), "v"(hi)); return r; }

struct StaticOrder {
    int nM, nN, nwg, G, c;
    __device__ void init(int M, int N, int G_, int c_) { nM = M / BM; nN = N / BM; nwg = nM * nN; G = G_; c = c_; }
    __device__ bool next(int i, int& pm, int& pn) const {
        const long L = (long)i * G + c; if (L >= nwg) return false;
        int wgid = (int)L; { const int q = nwg / NXCD, r = nwg % NXCD, xcd = wgid % NXCD, off = wgid / NXCD; wgid = (xcd < r ? xcd * (q + 1) : r * (q + 1) + (xcd - r) * q) + off; }
        const int nig = WGM * nN, gid = wgid / nig, fm = gid * WGM, gsz = (nM - fm) < WGM ? (nM - fm) : WGM;
        pm = fm + ((wgid % nig) % gsz); pn = (wgid % nig) / gsz; return true;
    }
};

template <class P, bool ALIGN_EPI>
__device__ __forceinline__ void gemm_phase(LAS unsigned char* lds, const P& S) {
    const int tid = threadIdx.x, wid = __builtin_amdgcn_readfirstlane(tid >> 6), lane = tid & 63, wr = wid >> 2, wc = wid & 3, fr = lane & 15, fq = lane >> 4;
    constexpr int nt = 16;
    int sR[2], sC[2]; unsigned voffB[2];
#pragma unroll
    for (int i = 0; i < 2; ++i) { int R, C; stage_rc(tid * 16 + i * 8192, R, C); sR[i] = R; sC[i] = C; const int Rb = P::PERM ? ((R & ~31) + perm32(R & 31)) : R; voffB[i] = (unsigned)(Rb * P::LDB + C) * 2u; }
    constexpr size_t kstep = (size_t)(BK * 2);
    constexpr size_t hstepB = (size_t)HALF * P::LDB * 2;
    const unsigned ldsw = (unsigned)wid * 1024u;
    const int aoff = lds_byte(wr * 64 + fr, fq * 8), boff = lds_byte(wc * 32 + fr, fq * 8);
#define PG8_SA(b, h) (((b) * 2 + (h)) * HTB)
#define PG8_SB(b, h) ((4 + (b) * 2 + (h)) * HTB)
#define PG8_STAGE(bufoff, gbase, voff) do { _Pragma("unroll") for (int _i = 0; _i < 2; ++_i) \
        __builtin_amdgcn_global_load_lds((const unsigned*)((const char*)(gbase) + (voff)[_i]), (LAS unsigned*)(lds + (bufoff) + ldsw + _i * 8192), 16, 0, 0); } while (0)
#define PG8_LDA(dst, b, h) do { _Pragma("unroll") for (int m = 0; m < 4; ++m) _Pragma("unroll") for (int k = 0; k < 2; ++k) dst[m][k] = *(const LAS bf16x8*)(lds + PG8_SA(b, h) + aoff + m * 2048 + k * 1024); } while (0)
#define PG8_LDB(dst, b, h) do { _Pragma("unroll") for (int n = 0; n < 2; ++n) _Pragma("unroll") for (int k = 0; k < 2; ++k) dst[n][k] = *(const LAS bf16x8*)(lds + PG8_SB(b, h) + boff + n * 2048 + k * 1024); } while (0)
#define PG8_MMA(ai, bj, At, Bt) do { __builtin_amdgcn_s_setprio(1); _Pragma("unroll") for (int m = 0; m < 4; ++m) _Pragma("unroll") for (int n = 0; n < 2; ++n) _Pragma("unroll") for (int k = 0; k < 2; ++k) \
        acc[ai][bj][m][n] = __builtin_amdgcn_mfma_f32_16x16x32_bf16(Bt[n][k], At[m][k], acc[ai][bj][m][n], 0, 0, 0); __builtin_amdgcn_s_setprio(0); } while (0)
#define PG8_WAIT_V(n) asm volatile("s_waitcnt vmcnt(" #n ")" ::: "memory")
#define PG8_WAIT_L(n) asm volatile("s_waitcnt lgkmcnt(" #n ")" ::: "memory")
#define PG8_BAR __builtin_amdgcn_s_barrier()
#define PG8_SCHED __builtin_amdgcn_sched_barrier(0)
    typename P::U cur, nxt; int ui = 0;
    if (!S.next(0, cur)) return;
    f32x4 acc[2][2][4][2];
#pragma unroll
    for (int a = 0; a < 2; ++a)
#pragma unroll
        for (int b = 0; b < 2; ++b)
#pragma unroll
            for (int m = 0; m < 4; ++m)
#pragma unroll
                for (int n = 0; n < 2; ++n) acc[a][b][m][n] = (f32x4){0.f, 0.f, 0.f, 0.f};
    bf16x8 At[4][2], B0[2][2], B1[2][2];
    unsigned offC[2][2], offN[2][2];
    S.a_off(cur, sR, sC, offC);
    const char* cA = S.a_base(cur); const char* cB = S.b_base(cur, 0);
    PG8_STAGE(PG8_SB(0, 0), cB, voffB); PG8_STAGE(PG8_SB(0, 1), cB + hstepB, voffB); PG8_STAGE(PG8_SA(0, 0), cA, offC[0]); PG8_STAGE(PG8_SA(0, 1), cA, offC[1]);
    if (wr == 1) PG8_BAR;
    PG8_WAIT_V(2); PG8_BAR;
    PG8_STAGE(PG8_SB(1, 0), cB + kstep, voffB); PG8_STAGE(PG8_SA(1, 0), cA + kstep, offC[0]); PG8_STAGE(PG8_SB(1, 1), cB + hstepB + kstep, voffB);
    PG8_WAIT_V(6); PG8_BAR;
    for (;;) {
        const bool has_next = S.next(ui + 1, nxt);
        const char* nA = cA; const char* nB = cB;
        if (has_next) { nA = S.a_base(nxt); nB = S.b_base(nxt, 0); }
        if constexpr (P::GATHER) {
            if (has_next) S.a_off(nxt, sR, sC, offN);
            else {
#pragma unroll
                for (int h = 0; h < 2; ++h)
#pragma unroll
                    for (int i = 0; i < 2; ++i) offN[h][i] = offC[h][i]; }
        }
#pragma nounroll
        for (int t = 0; t < nt; t += 2) {
            const bool last = (t == nt - 2);
            const char* a1 = cA + (size_t)(t + 1) * kstep;
            const char* a2 = last ? nA : cA + (size_t)(t + 2) * kstep; const char* b2 = last ? nB : S.b_base(cur, t + 2);
            const char* a3 = a2 + kstep; const char* b3 = b2 + kstep;
            unsigned o2[2][2];
#pragma unroll
            for (int h = 0; h < 2; ++h)
#pragma unroll
                for (int i = 0; i < 2; ++i) o2[h][i] = (P::GATHER && last) ? offN[h][i] : offC[h][i];
            PG8_LDB(B0, 0, 0); PG8_LDB(B1, 0, 1); PG8_SCHED; PG8_LDA(At, 0, 0); PG8_STAGE(PG8_SA(1, 1), a1, offC[1]);
            PG8_WAIT_V(8); PG8_WAIT_L(0); PG8_BAR; PG8_MMA(0, 0, At, B0); PG8_MMA(0, 1, At, B1); PG8_BAR; PG8_SCHED;
            PG8_LDA(At, 0, 1); PG8_STAGE(PG8_SB(0, 0), b2, voffB); PG8_STAGE(PG8_SB(0, 1), b2 + hstepB, voffB); PG8_STAGE(PG8_SA(0, 0), a2, o2[0]);
            PG8_WAIT_V(8); PG8_WAIT_L(0); PG8_BAR; PG8_MMA(1, 0, At, B0); PG8_MMA(1, 1, At, B1); PG8_BAR; PG8_SCHED;
            PG8_LDB(B0, 1, 0); PG8_LDB(B1, 1, 1); PG8_SCHED; PG8_LDA(At, 1, 0); PG8_STAGE(PG8_SA(0, 1), a2, o2[1]);
            PG8_WAIT_V(8); PG8_WAIT_L(0); PG8_BAR; PG8_MMA(0, 0, At, B0); PG8_MMA(0, 1, At, B1); PG8_BAR; PG8_SCHED;
            PG8_LDA(At, 1, 1); PG8_STAGE(PG8_SB(1, 0), b3, voffB); PG8_STAGE(PG8_SB(1, 1), b3 + hstepB, voffB); PG8_STAGE(PG8_SA(1, 0), a3, o2[0]);
            PG8_WAIT_V(8); PG8_WAIT_L(0); PG8_BAR; PG8_MMA(1, 0, At, B0); PG8_MMA(1, 1, At, B1); PG8_BAR; PG8_SCHED;
        }
        if constexpr (ALIGN_EPI) { if (wr == 0) PG8_BAR; }
        S.epi(acc, cur, wr, wc, fr, fq);
        if (!has_next) break;
#pragma unroll
        for (int a = 0; a < 2; ++a)
#pragma unroll
            for (int b = 0; b < 2; ++b)
#pragma unroll
                for (int m = 0; m < 4; ++m)
#pragma unroll
                    for (int n = 0; n < 2; ++n) acc[a][b][m][n] = (f32x4){0.f, 0.f, 0.f, 0.f};
        cur = nxt; cA = nA; cB = nB; ++ui;
        if constexpr (P::GATHER) {
#pragma unroll
            for (int h = 0; h < 2; ++h)
#pragma unroll
                for (int i = 0; i < 2; ++i) offC[h][i] = offN[h][i]; }
        if constexpr (ALIGN_EPI) { if (wr == 1) PG8_BAR; }
    }
    PG8_WAIT_V(0);
    if constexpr (!ALIGN_EPI) { if (wr == 0) PG8_BAR; }
    PG8_BAR;
#undef PG8_SA
#undef PG8_SB
#undef PG8_STAGE
#undef PG8_LDA
#undef PG8_LDB
#undef PG8_MMA
#undef PG8_WAIT_V
#undef PG8_WAIT_L
#undef PG8_BAR
#undef PG8_SCHED
}
}

struct Frame {
    LAS unsigned char* lds;
    gu32* ctl;
    unsigned char* ws;
    const float* in[20];
    float* out;
    int tid, lane, wave, G;
};
enum { I_X = 0, I_C, I_WADA, I_BADA, I_WIN, I_BG, I_MHW, I_WCONV, I_WOUT, I_LN1G, I_LN1B, I_WGRP, I_BGRP, I_WR, I_BR, I_WGATE, I_WUP, I_WDOWN, I_LN2G, I_LN2B };

struct UnitS { int pm, pn; };
struct PolInProj {
    typedef UnitS U; static constexpr bool PERM = true, GATHER = false; static constexpr int LDB = 1024;
    pg8::StaticOrder so; const char* A; const char* B; bf16* O;
    __device__ __forceinline__ bool next(int i, U& u) const { return so.next(i, u.pm, u.pn); }
    __device__ __forceinline__ const char* a_base(const U& u) const { return A + (size_t)u.pm * (256 * 2048); }
    __device__ __forceinline__ void a_off(const U&, const int (&sR)[2], const int (&sC)[2], unsigned (&o)[2][2]) const {
#pragma unroll
        for (int h = 0; h < 2; ++h)
#pragma unroll
            for (int i = 0; i < 2; ++i) o[h][i] = (unsigned)((h * 128 + sR[i]) * 1024 + sC[i]) * 2u; }
    __device__ __forceinline__ const char* b_base(const U& u, int kt) const { return B + (size_t)u.pn * (256 * 2048) + (size_t)kt * 128; }
    __device__ __forceinline__ void epi(const f32x4 (&acc)[2][2][4][2], const U& u, int wr, int wc, int fr, int fq) const {
        const int row0 = u.pm * 256 + wr * 64 + fr, col0 = u.pn * 256 + wc * 32 + 8 * fq;
#pragma unroll
        for (int ai = 0; ai < 2; ++ai)
#pragma unroll
            for (int m = 0; m < 4; ++m) { bf16* rowp = O + (size_t)(row0 + ai * 128 + m * 16) * DINW + col0;
#pragma unroll
                for (int bj = 0; bj < 2; ++bj) { const f32x4 v0 = acc[ai][bj][m][0], v1 = acc[ai][bj][m][1];
                    u32x4 w; w.x = pg8::cvt_pk_bf16(v0[0], v0[1]); w.y = pg8::cvt_pk_bf16(v0[2], v0[3]); w.z = pg8::cvt_pk_bf16(v1[0], v1[1]); w.w = pg8::cvt_pk_bf16(v1[2], v1[3]);
                    *(u32x4*)(rowp + bj * 128) = w; } }
    }
};
struct PolOutProj {
    typedef UnitS U; static constexpr bool PERM = false, GATHER = false; static constexpr int LDB = 1024;
    pg8::StaticOrder so; const char* A; const char* B; float* C;
    __device__ __forceinline__ bool next(int i, U& u) const { return so.next(i, u.pm, u.pn); }
    __device__ __forceinline__ const char* a_base(const U& u) const { return A + (size_t)u.pm * (256 * 2048); }
    __device__ __forceinline__ void a_off(const U&, const int (&sR)[2], const int (&sC)[2], unsigned (&o)[2][2]) const {
#pragma unroll
        for (int h = 0; h < 2; ++h)
#pragma unroll
            for (int i = 0; i < 2; ++i) o[h][i] = (unsigned)((h * 128 + sR[i]) * 1024 + sC[i]) * 2u; }
    __device__ __forceinline__ const char* b_base(const U& u, int kt) const { return B + (size_t)u.pn * (256 * 2048) + (size_t)kt * 128; }
    __device__ __forceinline__ void epi(const f32x4 (&acc)[2][2][4][2], const U& u, int wr, int wc, int fr, int fq) const {
        const int row0 = u.pm * 256 + wr * 64 + fr, col0 = u.pn * 256 + wc * 32 + 4 * fq;
#pragma unroll
        for (int ai = 0; ai < 2; ++ai)
#pragma unroll
            for (int m = 0; m < 4; ++m) { float* rowp = C + (size_t)(row0 + ai * 128 + m * 16) * D + col0;
#pragma unroll
                for (int bj = 0; bj < 2; ++bj)
#pragma unroll
                    for (int n = 0; n < 2; ++n) *(f32x4*)(rowp + bj * 128 + n * 16) = acc[ai][bj][m][n]; }
    }
};
struct UnitM { int tile, pn, cls, tb, cnt; };
__device__ __forceinline__ int pair_a(int p) { return p < 3 ? 0 : (p < 5 ? 1 : 2); }
__device__ __forceinline__ int pair_b(int p) { return p < 3 ? p + 1 : (p < 5 ? p - 1 : 3); }
struct PolMoeGU {
    typedef UnitM U; static constexpr bool PERM = true, GATHER = true; static constexpr int LDB = 1024;
    const LAS int* tcls; const LAS int* ttb; const LAS int* cnts; int NT, G, c;
    const char* A; const char* B  ; const RInfo* ri; bf16* H;
    __device__ __forceinline__ bool next(int i, U& u) const { const int L = i * G + c; const int tile = L >> 3; if (tile >= NT) return false;
        u.tile = tile; u.pn = L & 7; u.cls = tcls[tile]; u.tb = ttb[tile]; u.cnt = cnts[u.cls]; return true; }
    __device__ __forceinline__ const char* a_base(const U&) const { return A; }
    __device__ __forceinline__ void a_off(const U& u, const int (&sR)[2], const int (&sC)[2], unsigned (&o)[2][2]) const {
#pragma unroll
        for (int h = 0; h < 2; ++h)
#pragma unroll
            for (int i = 0; i < 2; ++i) { int rr = u.tb + h * 128 + sR[i]; if (rr >= u.cnt) rr = 0; const int tok = ri[(size_t)u.cls * CLS_CAP + rr].token; o[h][i] = (unsigned)tok * 2048u + (unsigned)sC[i] * 2u; } }
    __device__ __forceinline__ const char* b_base(const U& u, int kt) const { const int g = u.cls / 6, p = u.cls - g * 6, e = (u.pn >> 2) ? pair_b(p) : pair_a(p);
        return B + ((size_t)(g * 4 + e) * 1024 + (size_t)(u.pn & 3) * 256) * 2048 + (size_t)kt * 128; }
    __device__ __forceinline__ void epi(const f32x4 (&acc)[2][2][4][2], const U& u, int wr, int wc, int fr, int fq) const {
        const int slot = u.pn >> 2, ct = u.pn & 3;
#pragma unroll
        for (int ai = 0; ai < 2; ++ai)
#pragma unroll
            for (int m = 0; m < 4; ++m) { const int r = ai * 128 + wr * 64 + m * 16 + fr, rr = u.tb + r; const bool valid = rr < u.cnt;
                float w = 0.f; if (valid) { const RInfo* q = ri + (size_t)u.cls * CLS_CAP + rr; w = slot ? q->wb : q->wa; }
                float hv[8];
#pragma unroll
                for (int n = 0; n < 2; ++n)
#pragma unroll
                    for (int j = 0; j < 4; ++j) { const float g = acc[ai][0][m][n][j], up = acc[ai][1][m][n][j]; hv[n * 4 + j] = g * __builtin_amdgcn_rcpf(1.0f + __expf(-g)) * up * w; }
                u32x4 o; o.x = pg8::cvt_pk_bf16(hv[0], hv[1]); o.y = pg8::cvt_pk_bf16(hv[2], hv[3]); o.z = pg8::cvt_pk_bf16(hv[4], hv[5]); o.w = pg8::cvt_pk_bf16(hv[6], hv[7]);
                if (valid) *(u32x4*)(H + (size_t)(u.tile * 256 + r) * 1024 + slot * 512 + ct * 128 + wc * 32 + 8 * fq) = o; }
    }
};
struct PolMoeDown {
    typedef UnitM U; static constexpr bool PERM = true, GATHER = false; static constexpr int LDB = 512;
    const LAS int* tcls; const LAS int* ttb; const LAS int* cnts; int NT, G, c;
    const char* A  ; const char* B  ; const RInfo* ri; bf16* Y;
    __device__ __forceinline__ bool next(int i, U& u) const { const int L = i * G + c; const int tile = L >> 2; if (tile >= NT) return false;
        u.tile = tile; u.pn = L & 3; u.cls = tcls[tile]; u.tb = ttb[tile]; u.cnt = cnts[u.cls]; return true; }
    __device__ __forceinline__ const char* a_base(const U& u) const { return A + (size_t)u.tile * (256 * 2048); }
    __device__ __forceinline__ void a_off(const U&, const int (&sR)[2], const int (&sC)[2], unsigned (&o)[2][2]) const {
#pragma unroll
        for (int h = 0; h < 2; ++h)
#pragma unroll
            for (int i = 0; i < 2; ++i) o[h][i] = (unsigned)((h * 128 + sR[i]) * 1024 + sC[i]) * 2u; }
    __device__ __forceinline__ const char* b_base(const U& u, int kt) const { const int g = u.cls / 6, p = u.cls - g * 6, e = (kt >> 3) ? pair_b(p) : pair_a(p);
        return B + ((size_t)(g * 4 + e) * 1024 + (size_t)u.pn * 256) * 1024 + (size_t)(kt & 7) * 128; }
    __device__ __forceinline__ void epi(const f32x4 (&acc)[2][2][4][2], const U& u, int wr, int wc, int fr, int fq) const {
#pragma unroll
        for (int ai = 0; ai < 2; ++ai)
#pragma unroll
            for (int m = 0; m < 4; ++m) { const int r = ai * 128 + wr * 64 + m * 16 + fr, rr = u.tb + r; const bool valid = rr < u.cnt;
                if (valid) { const int tok = ri[(size_t)u.cls * CLS_CAP + rr].token; bf16* rowp = Y + (size_t)tok * D + u.pn * 256 + wc * 32 + 8 * fq;
#pragma unroll
                    for (int bj = 0; bj < 2; ++bj) { const f32x4 v0 = acc[ai][bj][m][0], v1 = acc[ai][bj][m][1];
                        u32x4 w; w.x = pg8::cvt_pk_bf16(v0[0], v0[1]); w.y = pg8::cvt_pk_bf16(v0[2], v0[3]); w.z = pg8::cvt_pk_bf16(v1[0], v1[1]); w.w = pg8::cvt_pk_bf16(v1[2], v1[3]);
                        *(u32x4*)(rowp + bj * 128) = w; } } }
    }
};

__device__ __forceinline__ void transpose_item(const float* W, int ldw, int k0, int n0, bf16* WT, int ldk, int drow0, float scale, LAS float* scr, int lane) {
#pragma unroll 8
    for (int i = 0; i < 32; ++i) { const int kk = 2 * i + (lane >> 5); scr[kk * 33 + (lane & 31)] = W[(size_t)(k0 + kk) * ldw + n0 + (lane & 31)]; }
    LDS_WAIT(); asm volatile("" ::: "memory");
    const int c = lane & 7;
#pragma unroll
    for (int j = 0; j < 4; ++j) { const int n = (lane >> 3) + 8 * j; const LAS float* s = scr + (8 * c) * 33 + n;
        u32x4 o; o.x = pk2(s[0 * 33] * scale, s[1 * 33] * scale); o.y = pk2(s[2 * 33] * scale, s[3 * 33] * scale); o.z = pk2(s[4 * 33] * scale, s[5 * 33] * scale); o.w = pk2(s[6 * 33] * scale, s[7 * 33] * scale);
        *(u32x4*)(WT + (size_t)(drow0 + n) * ldk + k0 + 8 * c) = o; }
    LDS_WAIT(); asm volatile("" ::: "memory");
}
__device__ __forceinline__ void phase_prologue(Frame& F) {
    {
        LAS float* scr = (LAS float*)(F.lds + F.wave * 16384);
        const int gw = blockIdx.x * NWAVES + F.wave, NGW = F.G * NWAVES;
        constexpr int I_IN = NL * 16 * 112, I_OUT = NL * 16 * 32, I_G = NL * 16 * 256, I_DN = NL * 16 * 256;
        constexpr int NITEMS = I_IN + I_OUT + 2 * I_G + I_DN;
        for (int it = gw; it < NITEMS; it += NGW) {
            int r = it;
            if (r < I_IN) { const int l = r / 1792, q = r % 1792, kb = q / 112, nb = q % 112, nd = nb * 32, ns = nd < 2048 ? nd : nd + 8;
                transpose_item(F.in[I_WIN] + (size_t)l * D * DIN_SRC, DIN_SRC, kb * 64, ns, (bf16*)(F.ws + WS_WIN) + (size_t)l * DINW * D, D, nd, nd < 512 ? QSCALE : 1.0f, scr, F.lane); continue; }
            r -= I_IN;
            if (r < I_OUT) { const int l = r / 512, q = r % 512, kb = q / 32, nb = q % 32;
                transpose_item(F.in[I_WOUT] + (size_t)l * D * D, D, kb * 64, nb * 32, (bf16*)(F.ws + WS_WOUT) + (size_t)l * D * D, D, nb * 32, 1.0f, scr, F.lane); continue; }
            r -= I_OUT;
            if (r < 2 * I_G) { const int up = r >= I_G; if (up) r -= I_G; const int mat = r / 256, q = r % 256, kb = q / 16, nb = q % 16, f0 = nb * 32;
                transpose_item(F.in[up ? I_WUP : I_WGATE] + (size_t)mat * D * 512, 512, kb * 64, f0, (bf16*)(F.ws + WS_WGU) + (size_t)mat * 1024 * 1024, 1024, (f0 >> 7) * 256 + (f0 & 127) + (up ? 128 : 0), 1.0f, scr, F.lane); continue; }
            r -= 2 * I_G;
            { const int mat = r / 256, q = r % 256, kb = q / 32, nb = q % 32;
                transpose_item(F.in[I_WDOWN] + (size_t)mat * 512 * D, D, kb * 64, nb * 32, (bf16*)(F.ws + WS_WD) + (size_t)mat * 1024 * 512, 512, nb * 32, 1.0f, scr, F.lane); }
        }
    }
    __syncthreads();
    {
        LAS float* cond = (LAS float*)F.lds;
        LAS float* red = (LAS float*)(F.lds + 65536);
        bool have = false;
        for (int un = blockIdx.x; un < NL * 192; un += F.G) {
            if (!have) { for (int i = F.tid; i < 16 * 1024; i += NTHR) { const float c = F.in[I_C][i]; cond[i] = c * sigmoidf_(c); } have = true; }
            __syncthreads();
            const int l = un / 192, n0 = (un % 192) * 32, n = F.tid & 31, ks = F.tid >> 5;
            const float* W = F.in[I_WADA] + (size_t)l * D * 6144 + n0 + n;
            float acc[16];
#pragma unroll
            for (int b = 0; b < 16; ++b) acc[b] = 0.f;
            for (int kk = 0; kk < 64; ++kk) { const int k = ks * 64 + kk; const float w = W[(size_t)k * 6144];
#pragma unroll
                for (int b = 0; b < 16; ++b) acc[b] += cond[b * 1024 + k] * w; }
#pragma unroll
            for (int b = 0; b < 16; ++b) red[(ks * 16 + b) * 32 + n] = acc[b];
            __syncthreads();
            { const int b = F.tid >> 5; float s = 0.f;
#pragma unroll
              for (int k2 = 0; k2 < 16; ++k2) s += red[(k2 * 16 + b) * 32 + n];
              ((float*)(F.ws + WS_MOD))[((size_t)l * 16 + b) * 6144 + n0 + n] = s + F.in[I_BADA][l * 6144 + n0 + n]; }
        }
    }
}

__device__ __forceinline__ void stage_cols_T(LAS float* dst, const float* src, int ld, int col0, int NC, int tid) {
    for (int idx = tid; idx < NC * 1024; idx += NTHR) { const int k = idx / NC, c = idx - k * NC; dst[c * 1024 + k] = src[(size_t)k * ld + col0 + c]; }
}
__device__ __forceinline__ void modulate_gates(Frame& F, const f32x4 (&xo)[4], int m, int lg, const LAS float* wgT) {
    const float* mod = (const float*)(F.ws + WS_MOD) + ((size_t)lg * 16 + (m >> 11)) * 6144;
    f32x4 u[4];
#pragma unroll
    for (int j = 0; j < 4; ++j) { const int col = 256 * j + 4 * F.lane; const f32x4 sh = *(const f32x4*)(mod + col), sc = *(const f32x4*)(mod + 1024 + col); u[j] = xo[j] * (1.0f + sc) + sh; }
    bf16* up = (bf16*)(F.ws + WS_UA) + (size_t)m * D;
#pragma unroll
    for (int j = 0; j < 4; ++j) { u32x2 w; w.x = pk2(u[j][0], u[j][1]); w.y = pk2(u[j][2], u[j][3]); *(u32x2*)(up + 256 * j + 4 * F.lane) = w; }
    float g[8];
#pragma unroll
    for (int c = 0; c < 8; ++c) { float s = 0.f;
#pragma unroll
        for (int j = 0; j < 4; ++j) { const f32x4 w = *(const LAS f32x4*)(wgT + c * 1024 + 256 * j + 4 * F.lane); s += (u[j][0] * w[0] + u[j][1] * w[1]) + (u[j][2] * w[2] + u[j][3] * w[3]); }
        g[c] = wave_sum(s); }
    float val = g[0];
#pragma unroll
    for (int c = 1; c < 8; ++c) val = (F.lane == c) ? g[c] : val;
    if (F.lane < 8) ((float*)(F.ws + WS_GATES))[(size_t)m * 8 + F.lane] = val + F.in[I_BG][lg * 8 + F.lane];
}
__device__ __forceinline__ void ln_row(f32x4 (&z)[4], const float* g, const float* b, int lane) {
    float s = 0.f;
#pragma unroll
    for (int j = 0; j < 4; ++j) s += (z[j][0] + z[j][1]) + (z[j][2] + z[j][3]);
    const float mean = wave_sum(s) * (1.0f / D); float q = 0.f;
#pragma unroll
    for (int j = 0; j < 4; ++j) { z[j] = z[j] - mean; q += (z[j][0] * z[j][0] + z[j][1] * z[j][1]) + (z[j][2] * z[j][2] + z[j][3] * z[j][3]); }
    const float rstd = 1.0f / sqrtf(wave_sum(q) * (1.0f / D) + LN_EPS);
#pragma unroll
    for (int j = 0; j < 4; ++j) { const int col = 256 * j + 4 * lane; const f32x4 gg = *(const f32x4*)(g + col), bb = *(const f32x4*)(b + col); z[j] = z[j] * rstd * gg + bb; }
}
__device__ __forceinline__ void phase_rowA(Frame& F) {
    LAS float* wgT = (LAS float*)(F.lds + 81920);
    stage_cols_T(wgT, F.in[I_WIN], DIN_SRC, 2048, 8, F.tid);
    __syncthreads();
    const int gw = blockIdx.x * NWAVES + F.wave, NGW = F.G * NWAVES;
    for (int m = gw; m < T; m += NGW) {
        f32x4 x[4];
#pragma unroll
        for (int j = 0; j < 4; ++j) x[j] = *(const f32x4*)(F.in[I_X] + (size_t)m * D + 256 * j + 4 * F.lane);
        modulate_gates(F, x, m, 0, wgT);
    }
}
__device__ __forceinline__ void phase_rowB(Frame& F, int l) {
    LAS float* wrT = (LAS float*)F.lds;
    LAS int* lcnt = (LAS int*)(F.lds + MISC_OFF + MO_LCNT);
    LAS int* lbase = (LAS int*)(F.lds + MISC_OFF + MO_LBASE);
    LAS int* rec = (LAS int*)(F.lds + MISC_OFF + MO_REC);
    stage_cols_T(wrT, F.in[I_WGRP] + (size_t)l * D * 4, 4, 0, 4, F.tid);
    stage_cols_T(wrT + 4 * 1024, F.in[I_WR] + (size_t)l * D * 16, 16, 0, 16, F.tid);
    if (F.tid < NCLS) lcnt[F.tid] = 0;
    __syncthreads();
    const float* xcur = (l == 0) ? F.in[I_X] : F.out;
    const float* mix = (const float*)(F.ws + WS_BIG);
    float* x1p = (float*)(F.ws + WS_X1);
    RInfo* ri = (RInfo*)(F.ws + WS_RINFO);
    for (int rb = blockIdx.x; rb < T / 128; rb += F.G) {
        for (int rl = F.wave; rl < 128; rl += NWAVES) {
            const int m = rb * 128 + rl;
            const float* mod = (const float*)(F.ws + WS_MOD) + ((size_t)l * 16 + (m >> 11)) * 6144;
            f32x4 z[4];
#pragma unroll
            for (int j = 0; j < 4; ++j) { const int col = 256 * j + 4 * F.lane; const f32x4 xv = *(const f32x4*)(xcur + (size_t)m * D + col), mv = *(const f32x4*)(mix + (size_t)m * D + col), gt = *(const f32x4*)(mod + 2048 + col);
                z[j] = xv * ALPHA + (1.0f + gt) * mv; }
            ln_row(z, F.in[I_LN1G] + l * D, F.in[I_LN1B] + l * D, F.lane);
            f32x4 u[4];
#pragma unroll
            for (int j = 0; j < 4; ++j) { const int col = 256 * j + 4 * F.lane; *(f32x4*)(x1p + (size_t)m * D + col) = z[j];
                const f32x4 sh = *(const f32x4*)(mod + 3072 + col), sc = *(const f32x4*)(mod + 4096 + col); u[j] = z[j] * (1.0f + sc) + sh; }
            bf16* up = (bf16*)(F.ws + WS_UA) + (size_t)m * D;
#pragma unroll
            for (int j = 0; j < 4; ++j) { u32x2 w; w.x = pk2(u[j][0], u[j][1]); w.y = pk2(u[j][2], u[j][3]); *(u32x2*)(up + 256 * j + 4 * F.lane) = w; }
            float lg[20];
#pragma unroll
            for (int c = 0; c < 20; ++c) { float s = 0.f;
#pragma unroll
                for (int j = 0; j < 4; ++j) { const f32x4 w = *(const LAS f32x4*)(wrT + c * 1024 + 256 * j + 4 * F.lane); s += (u[j][0] * w[0] + u[j][1] * w[1]) + (u[j][2] * w[2] + u[j][3] * w[3]); }
                lg[c] = wave_sum(s); }
            float gl[4];
#pragma unroll
            for (int j = 0; j < 4; ++j) gl[j] = lg[j] + F.in[I_BGRP][l * 4 + j];
            int gi = 0; float gm = gl[0];
#pragma unroll
            for (int j = 1; j < 4; ++j) if (gl[j] > gm) { gm = gl[j]; gi = j; }
            float den = 0.f;
#pragma unroll
            for (int j = 0; j < 4; ++j) den += __expf(gl[j] - gm);
            const float grp_w = 1.0f / den;
            float el[4];
#pragma unroll
            for (int e = 0; e < 4; ++e) { float v = lg[4 + e];
#pragma unroll
                for (int g2 = 1; g2 < 4; ++g2) v = (gi == g2) ? lg[4 + g2 * 4 + e] : v;
                el[e] = v + F.in[I_BR][l * 16 + gi * 4 + e]; }
            int i1 = 0; float v1 = el[0];
#pragma unroll
            for (int e = 1; e < 4; ++e) if (el[e] > v1) { v1 = el[e]; i1 = e; }
            int i2 = -1; float v2 = -3.0e38f;
#pragma unroll
            for (int e = 0; e < 4; ++e) if (e != i1 && el[e] > v2) { v2 = el[e]; i2 = e; }
            const float ex = __expf(v2 - v1), w1 = grp_w / (1.0f + ex), w2 = grp_w * ex / (1.0f + ex);
            const int ea = i1 < i2 ? i1 : i2, eb = i1 < i2 ? i2 : i1; const float wa = i1 < i2 ? w1 : w2, wb = i1 < i2 ? w2 : w1;
            const int p = ea == 0 ? eb - 1 : (ea == 1 ? eb + 1 : 5), cls = gi * 6 + p;
            if (F.lane == 0) { const int lr = __hip_atomic_fetch_add(lcnt + cls, 1, __ATOMIC_RELAXED, __HIP_MEMORY_SCOPE_WORKGROUP);
                rec[rl * 4 + 0] = cls; rec[rl * 4 + 1] = lr; rec[rl * 4 + 2] = __builtin_bit_cast(int, wa); rec[rl * 4 + 3] = __builtin_bit_cast(int, wb); }
        }
        __syncthreads();
        if (F.tid < NCLS) { const int n = lcnt[F.tid]; lbase[F.tid] = n ? (int)__hip_atomic_fetch_add(F.ctl + CW_CNT + l * 32 + F.tid, (unsigned)n, RLX_AGENT) : 0; }
        __syncthreads();
        if (F.tid < 128) { const int cls = rec[F.tid * 4], pos = lbase[cls] + rec[F.tid * 4 + 1];
            RInfo r; r.token = rb * 128 + F.tid; r.wa = __builtin_bit_cast(float, rec[F.tid * 4 + 2]); r.wb = __builtin_bit_cast(float, rec[F.tid * 4 + 3]); r.pad = 0;
            ri[(size_t)cls * CLS_CAP + pos] = r; }
        __syncthreads();
        if (F.tid < NCLS) lcnt[F.tid] = 0;
        __syncthreads();
    }
}
__device__ __forceinline__ void phase_rowC(Frame& F, int l) {
    LAS float* wgT = (LAS float*)(F.lds + 81920);
    if (l + 1 < NL) stage_cols_T(wgT, F.in[I_WIN] + (size_t)(l + 1) * D * DIN_SRC, DIN_SRC, 2048, 8, F.tid);
    __syncthreads();
    const float* x1p = (const float*)(F.ws + WS_X1); const bf16* yp = (const bf16*)(F.ws + WS_Y);
    const int gw = blockIdx.x * NWAVES + F.wave, NGW = F.G * NWAVES;
    for (int m = gw; m < T; m += NGW) {
        const float* mod = (const float*)(F.ws + WS_MOD) + ((size_t)l * 16 + (m >> 11)) * 6144;
        f32x4 z[4];
#pragma unroll
        for (int j = 0; j < 4; ++j) { const int col = 256 * j + 4 * F.lane; const f32x4 xv = *(const f32x4*)(x1p + (size_t)m * D + col), gt = *(const f32x4*)(mod + 5120 + col); const u32x2 yw = *(const u32x2*)(yp + (size_t)m * D + col);
            const f32x4 yv = (f32x4){bf_lo(yw.x), bf_hi(yw.x), bf_lo(yw.y), bf_hi(yw.y)};
            z[j] = xv * ALPHA + (1.0f + gt) * yv; }
        ln_row(z, F.in[I_LN2G] + l * D, F.in[I_LN2B] + l * D, F.lane);
#pragma unroll
        for (int j = 0; j < 4; ++j) *(f32x4*)(F.out + (size_t)m * D + 256 * j + 4 * F.lane) = z[j];
        if (l + 1 < NL) modulate_gates(F, z, m, l + 1, wgT);
    }
}

__device__ __forceinline__ void mlstm_naive_unit(Frame& F, int l, int bh) {
    const int b = bh >> 2, h = bh & 3, tid = F.tid, v = tid >> 2, kp = tid & 3;
    LAS float* Qs = (LAS float*)F.lds; LAS float* Ks = Qs + 64 * 128; LAS float* Vs = Ks + 64 * 128; LAS float* Hb = Vs + 64 * 128;
    LAS float* sg = (LAS float*)(F.lds + MISC_OFF + MO_SG);
    const bf16* proj = (const bf16*)(F.ws + WS_BIG); const float* gates = (const float*)(F.ws + WS_GATES);
    bf16* outp = (bf16*)(F.ws + WS_UA);
    float C[32], nn[32];
#pragma unroll
    for (int j = 0; j < 32; ++j) { C[j] = 0.f; nn[j] = 0.f; }
    float mst = 0.f;
    for (int blk = 0; blk < SEQ / 64; ++blk) {
        const int tok0 = b * SEQ + blk * 64;
#pragma unroll
        for (int i = 0; i < 2; ++i) { const int idx = tid + i * NTHR, row = idx >> 4, c8 = idx & 15; const bf16* p = proj + (size_t)(tok0 + row) * DINW + h * 128 + c8 * 8;
            const u32x4 q = *(const u32x4*)p, k = *(const u32x4*)(p + 512), vv = *(const u32x4*)(p + 1024);
            LAS float* dq = Qs + row * 128 + c8 * 8; LAS float* dk = Ks + row * 128 + c8 * 8; LAS float* dv = Vs + row * 128 + c8 * 8;
#pragma unroll
            for (int e = 0; e < 4; ++e) { dq[2 * e] = bf_lo(q[e]); dq[2 * e + 1] = bf_hi(q[e]); dk[2 * e] = bf_lo(k[e]); dk[2 * e + 1] = bf_hi(k[e]); dv[2 * e] = bf_lo(vv[e]); dv[2 * e + 1] = bf_hi(vv[e]); } }
        if (tid < 64) { const float ip = gates[(size_t)(tok0 + tid) * 8 + h], fp = gates[(size_t)(tok0 + tid) * 8 + 4 + h];
            const float lf = fminf(fp, 0.f) - log1pf(__expf(-fabsf(fp)));
            sg[tid * 2] = lf; sg[tid * 2 + 1] = ip; }
        __syncthreads();
        for (int t = 0; t < 64; ++t) {
            const float lf = sg[t * 2], ig = sg[t * 2 + 1];
            const float mnew = fmaxf(lf + mst, ig), fd = __expf(lf + mst - mnew), ii = __expf(ig - mnew); mst = mnew;
            const float vv = Vs[t * 128 + v] * ii;
            float hp = 0.f, dp = 0.f;
#pragma unroll
            for (int j4 = 0; j4 < 8; ++j4) { const f32x4 kk = *(const LAS f32x4*)(Ks + t * 128 + kp * 32 + j4 * 4), qq = *(const LAS f32x4*)(Qs + t * 128 + kp * 32 + j4 * 4);
#pragma unroll
                for (int e = 0; e < 4; ++e) { const int j = j4 * 4 + e; C[j] = fd * C[j] + vv * kk[e]; nn[j] = fd * nn[j] + ii * kk[e]; hp += C[j] * qq[e]; dp += nn[j] * qq[e]; } }
            hp += __shfl_xor(hp, 1); hp += __shfl_xor(hp, 2); dp += __shfl_xor(dp, 1); dp += __shfl_xor(dp, 2);
            const float hv = hp / fmaxf(fabsf(dp), __expf(-mst));
            if (kp == 0) Hb[t * 128 + v] = hv;
        }
        __syncthreads();
        { const int t = tid >> 3, part = tid & 7; float x[16]; float s = 0.f;
#pragma unroll
          for (int j = 0; j < 16; ++j) { x[j] = Hb[t * 128 + part * 16 + j]; s += x[j]; }
          s += __shfl_xor(s, 1); s += __shfl_xor(s, 2); s += __shfl_xor(s, 4);
          const float mean = s * (1.0f / 128.0f); float q = 0.f;
#pragma unroll
          for (int j = 0; j < 16; ++j) { x[j] -= mean; q += x[j] * x[j]; }
          q += __shfl_xor(q, 1); q += __shfl_xor(q, 2); q += __shfl_xor(q, 4);
          const float rstd = 1.0f / sqrtf(q * (1.0f / 128.0f) + LN_EPS);
          const bf16* op = proj + (size_t)(tok0 + t) * DINW + 1536 + h * 128 + part * 16; const float* wn = F.in[I_MHW] + l * 512 + h * 128 + part * 16;
          const u32x4 o0 = *(const u32x4*)op, o1 = *(const u32x4*)(op + 8);
          float r[16];
#pragma unroll
          for (int e = 0; e < 4; ++e) { r[2 * e] = bf_lo(o0[e]); r[2 * e + 1] = bf_hi(o0[e]); r[8 + 2 * e] = bf_lo(o1[e]); r[8 + 2 * e + 1] = bf_hi(o1[e]); }
#pragma unroll
          for (int j = 0; j < 16; ++j) r[j] = x[j] * rstd * wn[j] * sigmoidf_(r[j]);
          u32x4 w0, w1;
#pragma unroll
          for (int e = 0; e < 4; ++e) { w0[e] = pk2(r[2 * e], r[2 * e + 1]); w1[e] = pk2(r[8 + 2 * e], r[8 + 2 * e + 1]); }
          bf16* dp2 = outp + (size_t)(tok0 + t) * D + h * 128 + part * 16; *(u32x4*)dp2 = w0; *(u32x4*)(dp2 + 8) = w1; }
        __syncthreads();
    }
}
__device__ __forceinline__ void conv_items(Frame& F, int l, int first_block, int nblocks) {
    const bf16* proj = (const bf16*)(F.ws + WS_BIG); bf16* outp = (bf16*)(F.ws + WS_UA);
    const int nthreads = nblocks * NTHR;
    for (int id = (blockIdx.x - first_block) * NTHR + F.tid; id < (T / 32) * 64; id += nthreads) {
        const int cg = id & 63, run = id >> 6, t0 = run * 32, c0 = cg * 8;
        float w[3][8];
#pragma unroll
        for (int j = 0; j < 3; ++j)
#pragma unroll
            for (int e = 0; e < 8; ++e) w[j][e] = F.in[I_WCONV][(size_t)l * 3 * 512 + j * 512 + c0 + e];
        float z1[8], z2[8];
#pragma unroll
        for (int e = 0; e < 8; ++e) { z1[e] = 0.f; z2[e] = 0.f; }
        if ((t0 & (SEQ - 1)) != 0) {
#pragma unroll
            for (int back = 1; back <= 2; ++back) { const bf16* p = proj + (size_t)(t0 - back) * DINW + 2560 + c0; const u32x4 cc = *(const u32x4*)p, ch = *(const u32x4*)(p + 512);
#pragma unroll
                for (int e = 0; e < 4; ++e) { const float a = bf_lo(cc[e]) * bf_lo(ch[e]), b2 = bf_hi(cc[e]) * bf_hi(ch[e]); if (back == 1) { z1[2 * e] = a; z1[2 * e + 1] = b2; } else { z2[2 * e] = a; z2[2 * e + 1] = b2; } } }
        }
        for (int t = t0; t < t0 + 32; ++t) { const bf16* p = proj + (size_t)t * DINW + 2048 + c0; const u32x4 cb = *(const u32x4*)p, cc = *(const u32x4*)(p + 512), ch = *(const u32x4*)(p + 1024);
            float z0[8], y[8];
#pragma unroll
            for (int e = 0; e < 4; ++e) { z0[2 * e] = bf_lo(cc[e]) * bf_lo(ch[e]); z0[2 * e + 1] = bf_hi(cc[e]) * bf_hi(ch[e]); }
#pragma unroll
            for (int e = 0; e < 4; ++e) { y[2 * e] = bf_lo(cb[e]) * (w[0][2 * e] * z2[2 * e] + w[1][2 * e] * z1[2 * e] + w[2][2 * e] * z0[2 * e]);
                y[2 * e + 1] = bf_hi(cb[e]) * (w[0][2 * e + 1] * z2[2 * e + 1] + w[1][2 * e + 1] * z1[2 * e + 1] + w[2][2 * e + 1] * z0[2 * e + 1]); }
            u32x4 o;
#pragma unroll
            for (int e = 0; e < 4; ++e) o[e] = pk2(y[2 * e], y[2 * e + 1]);
            *(u32x4*)(outp + (size_t)t * D + 512 + c0) = o;
#pragma unroll
            for (int e = 0; e < 8; ++e) { z2[e] = z1[e]; z1[e] = z0[e]; } }
    }
}
__device__ __forceinline__ void phase_mixer(Frame& F, int l) {
    const int nm = F.G > 64 ? 64 : 0;
    if (nm) { if ((int)blockIdx.x < 64) mlstm_naive_unit(F, l, blockIdx.x); else conv_items(F, l, 64, F.G - 64); }
    else { for (int u = blockIdx.x; u < 64; u += F.G) mlstm_naive_unit(F, l, u); conv_items(F, l, 0, F.G); }
}

__device__ __forceinline__ int moe_tables(Frame& F, int l) {
    LAS int* tcls = (LAS int*)(F.lds + MISC_OFF + MO_TCLS); LAS int* ttb = (LAS int*)(F.lds + MISC_OFF + MO_TTB); LAS int* cnts = (LAS int*)(F.lds + MISC_OFF + MO_CNT); LAS int* ntp = (LAS int*)(F.lds + MISC_OFF + MO_NT);
    __syncthreads();
    if (F.tid == 0) { int t = 0;
        for (int c = 0; c < NCLS; ++c) { int n = (int)__hip_atomic_load(F.ctl + CW_CNT + l * 32 + c, RLX_AGENT); if (n > CLS_CAP) n = CLS_CAP; cnts[c] = n;
            for (int j = 0; j * 256 < n && t < MAXTILES; ++j) { tcls[t] = c; ttb[t] = j * 256; ++t; } }
        ntp[0] = t; }
    __syncthreads();
    return ntp[0];
}
__device__ __forceinline__ void phase_moe_gu(Frame& F, int l) {
    const int NT = moe_tables(F, l);
    PolMoeGU P; P.tcls = (const LAS int*)(F.lds + MISC_OFF + MO_TCLS); P.ttb = (const LAS int*)(F.lds + MISC_OFF + MO_TTB); P.cnts = (const LAS int*)(F.lds + MISC_OFF + MO_CNT);
    P.NT = NT; P.G = F.G; P.c = blockIdx.x; P.A = (const char*)(F.ws + WS_UA); P.B = (const char*)(F.ws + WS_WGU) + (size_t)l * 16 * 1024 * 2048; P.ri = (const RInfo*)(F.ws + WS_RINFO); P.H = (bf16*)(F.ws + WS_BIG);
    pg8::gemm_phase<PolMoeGU, true>(F.lds, P);
}
__device__ __forceinline__ void phase_moe_down(Frame& F, int l) {
    const int NT = moe_tables(F, l);
    PolMoeDown P; P.tcls = (const LAS int*)(F.lds + MISC_OFF + MO_TCLS); P.ttb = (const LAS int*)(F.lds + MISC_OFF + MO_TTB); P.cnts = (const LAS int*)(F.lds + MISC_OFF + MO_CNT);
    P.NT = NT; P.G = F.G; P.c = blockIdx.x; P.A = (const char*)(F.ws + WS_BIG); P.B = (const char*)(F.ws + WS_WD) + (size_t)l * 16 * 1024 * 1024; P.ri = (const RInfo*)(F.ws + WS_RINFO); P.Y = (bf16*)(F.ws + WS_Y);
    pg8::gemm_phase<PolMoeDown, true>(F.lds, P);
}
__device__ __forceinline__ void phase_inproj(Frame& F, int l) {
    PolInProj P; P.so.init(T, DINW, F.G, blockIdx.x); P.A = (const char*)(F.ws + WS_UA); P.B = (const char*)(F.ws + WS_WIN) + (size_t)l * DINW * 2048; P.O = (bf16*)(F.ws + WS_BIG);
    pg8::gemm_phase<PolInProj, true>(F.lds, P);
}
__device__ __forceinline__ void phase_outproj(Frame& F, int l) {
    PolOutProj P; P.so.init(T, D, F.G, blockIdx.x); P.A = (const char*)(F.ws + WS_UA); P.B = (const char*)(F.ws + WS_WOUT) + (size_t)l * D * 2048; P.C = (float*)(F.ws + WS_BIG);
    pg8::gemm_phase<PolOutProj, true>(F.lds, P);
}

struct Args { const float* in[20]; float* out; unsigned char* ws; int l, pad; };
enum { PH_PRO = 0, PH_ROWA, PH_INPROJ, PH_MIXER, PH_OUTPROJ, PH_ROWB, PH_MOEGU, PH_MOEDOWN, PH_ROWC };
template <int PH>
__global__ void __launch_bounds__(NTHR, 2) k_phase(Args args) {
    extern __shared__ __attribute__((aligned(16))) unsigned char lds[];
    Frame F;
    F.lds = (LAS unsigned char*)lds; F.ws = args.ws; F.ctl = (gu32*)(args.ws + WS_CTL); F.out = args.out;
#pragma unroll
    for (int i = 0; i < 20; ++i) F.in[i] = args.in[i];
    F.tid = threadIdx.x; F.lane = F.tid & 63; F.wave = __builtin_amdgcn_readfirstlane(F.tid >> 6); F.G = gridDim.x;
    const int l = args.l;
    if constexpr (PH == PH_PRO) phase_prologue(F);
    if constexpr (PH == PH_ROWA) phase_rowA(F);
    if constexpr (PH == PH_INPROJ) phase_inproj(F, l);
    if constexpr (PH == PH_MIXER) phase_mixer(F, l);
    if constexpr (PH == PH_OUTPROJ) phase_outproj(F, l);
    if constexpr (PH == PH_ROWB) phase_rowB(F, l);
    if constexpr (PH == PH_MOEGU) phase_moe_gu(F, l);
    if constexpr (PH == PH_MOEDOWN) phase_moe_down(F, l);
    if constexpr (PH == PH_ROWC) phase_rowC(F, l);
}

template <int PH> static bool launch_phase(const Args& a, int grid, hipStream_t stream) {
    static bool attr = false;
    if (!attr) { if (hipFuncSetAttribute((const void*)k_phase<PH>, hipFuncAttributeMaxDynamicSharedMemorySize, LDS_BYTES) != hipSuccess) { fprintf(stderr, "kernel_launch: hipFuncSetAttribute failed (phase %d)\n", PH); return false; } attr = true; }
    hipLaunchKernelGGL(k_phase<PH>, dim3(grid), dim3(NTHR), LDS_BYTES, stream, a);
    const hipError_t le = hipPeekAtLastError();
    if (le != hipSuccess) { fprintf(stderr, "kernel_launch: launch of phase %d failed: %s\n", PH, hipGetErrorName(le)); return false; }
    return true;
}

extern "C" void kernel_launch(void* const* d_in, const int* in_sizes, int n_in, void* d_out, int out_size, void* d_ws, size_t ws_size, hipStream_t stream) {
    static int grid = 0;
    if (grid == 0) {
        if (n_in != 20 || in_sizes[0] != T * D || out_size != T * D || ws_size < WS_END) { fprintf(stderr, "kernel_launch: unexpected shapes (n_in %d, in0 %d, out %d, ws %zu < %zu)\n", n_in, n_in > 0 ? in_sizes[0] : -1, out_size, ws_size, (size_t)WS_END); grid = -1; return; }
        int dev = 0, cus = 0;
        if (hipGetDevice(&dev) != hipSuccess || hipDeviceGetAttribute(&cus, hipDeviceAttributeMultiprocessorCount, dev) != hipSuccess) { grid = -1; return; }
        grid = cus;
    }
    if (grid < 0) return;
    if (hipMemsetAsync((char*)d_ws + WS_CTL, 0, CTL_ZERO_BYTES, stream) != hipSuccess) return;
    Args a{};
    for (int i = 0; i < 20; ++i) a.in[i] = (const float*)d_in[i];
    a.out = (float*)d_out; a.ws = (unsigned char*)d_ws; a.l = 0; a.pad = 0;
    int nl = 0;
#define DBG_NLAUNCH 99
#define LP(PH) do { if (nl++ >= DBG_NLAUNCH) return; if (!launch_phase<PH>(a, grid, stream)) return; } while (0)
    LP(PH_PRO);
    LP(PH_ROWA);
    for (int l = 0; l < NL; ++l) {
        a.l = l;
        LP(PH_INPROJ); LP(PH_MIXER); LP(PH_OUTPROJ); LP(PH_ROWB); LP(PH_MOEGU); LP(PH_MOEDOWN); LP(PH_ROWC);
    }
}
```

```cpp
#include <hip/hip_runtime.h>
#include <cstdio>
#include <cstdint>

#define GAS __attribute__((address_space(1)))
#define LAS __attribute__((address_space(3)))
typedef unsigned short bf16;
typedef short bf16x8 __attribute__((ext_vector_type(8)));
typedef float f32x4 __attribute__((ext_vector_type(4)));
typedef float f32x2 __attribute__((ext_vector_type(2)));
typedef unsigned u32x4 __attribute__((ext_vector_type(4)));
typedef unsigned u32x2 __attribute__((ext_vector_type(2)));
typedef GAS unsigned gu32;
#define RLX_AGENT __ATOMIC_RELAXED, __HIP_MEMORY_SCOPE_AGENT
#define LDS_WAIT() asm volatile("s_waitcnt lgkmcnt(0)" ::: "memory")
#define VM_WAIT() asm volatile("s_waitcnt vmcnt(0)" ::: "memory")

constexpr int T = 32768, D = 1024, SEQ = 2048, NL = 2, DINW = 3584, DIN_SRC = 3592;
constexpr int NCLS = 24, CLS_CAP = 32768, MAXTILES = 160;
constexpr float ALPHA = 1.41421356237309505f, LN_EPS = 1e-5f, QSCALE = 0.08838834764831845f;
constexpr int NWAVES = 8, NTHR = 512;

constexpr size_t MiB = 1u << 20;
constexpr size_t WS_CTL = 0, CTL_ZERO_BYTES = 1 * MiB;
constexpr size_t WS_MOD = 1 * MiB;
constexpr size_t WS_GATES = 2 * MiB;
constexpr size_t WS_RINFO = 4 * MiB;
constexpr size_t WS_WIN = 16 * MiB;
constexpr size_t WS_WOUT = 30 * MiB;
constexpr size_t WS_WGU = 34 * MiB;
constexpr size_t WS_WD = 98 * MiB;
constexpr size_t WS_UA = 130 * MiB;
constexpr size_t WS_BIG = 194 * MiB;
constexpr size_t WS_X1 = WS_BIG + 128 * MiB;
constexpr size_t WS_Y = WS_UA;
constexpr size_t WS_END = 450 * MiB;
static_assert((size_t)(T + NCLS * 256) * 1024 * 2 <= 128 * MiB, "HID fits below X1");
constexpr int CW_TMO = 0, CW_CODE = 1, CW_CNT = 64, CW_BAR = 4096;

constexpr int RING_BYTES = 131072, MISC_OFF = RING_BYTES, LDS_BYTES = 147456;
constexpr int MO_BAR = 0, MO_TCLS = 64, MO_TTB = 1024, MO_CNT = 2048, MO_NT = 2176, MO_LCNT = 2304, MO_LBASE = 2432, MO_REC = 4096, MO_SG = 8192;

struct RInfo { int token; float wa; float wb; int pad; };

__device__ __forceinline__ unsigned f2bf(float f) { unsigned u = __builtin_bit_cast(unsigned, f); return (u + 0x7fffu + ((u >> 16) & 1u)) >> 16; }
__device__ __forceinline__ unsigned pk2(float lo, float hi) { return f2bf(lo) | (f2bf(hi) << 16); }
__device__ __forceinline__ float bf_lo(unsigned w) { return __builtin_bit_cast(float, w << 16); }
__device__ __forceinline__ float bf_hi(unsigned w) { return __builtin_bit_cast(float, w & 0xffff0000u); }
__device__ __forceinline__ float wave_sum(float v) {
#pragma unroll
    for (int o = 1; o < 64; o <<= 1) v += __shfl_xor(v, o);
    return v;
}
__device__ __forceinline__ float sigmoidf_(float x) { return 1.0f / (1.0f + __expf(-x)); }

__device__ __forceinline__ int opaque_tid() {
    int w = __builtin_amdgcn_readfirstlane(threadIdx.x >> 6); asm volatile("" : "+s"(w));
    int l = __builtin_amdgcn_mbcnt_hi(~0u, __builtin_amdgcn_mbcnt_lo(~0u, 0u)); asm volatile("" : "+v"(l));
    return w * 64 + l; }
namespace pg8 {
constexpr int BM = 256, BK = 64, HALF = 128, HTB = HALF * BK * 2, STAGE_BYTES = 8 * HTB, NXCD = 8, WGM = 8;
__host__ __device__ __forceinline__ int lds_byte(int r, int c) { const int st = (r >> 4) * 2 + (c >> 5), rr = r & 15, cc = c & 31, ob = rr * 64 + cc * 2; return st * 1024 + (ob ^ (((ob >> 9) & 1) << 5)); }
__host__ __device__ __forceinline__ void stage_rc(int b, int& R, int& C) { const int st = b / 1024, sb = b % 1024, swz = sb ^ (((sb >> 9) & 1) << 5); R = (st >> 1) * 16 + swz / 64; C = (st & 1) * 32 + (swz % 64) / 2; }
__host__ __device__ __forceinline__ int perm32(int rho) { const int n = rho >> 4, i = rho & 15; return 8 * (i >> 2) + 4 * n + (i & 3); }
__device__ __forceinline__ unsigned cvt_pk_bf16(float lo, float hi) { unsigned r; asm volatile("v_cvt_pk_bf16_f32 %0, %1, %2" : "=v"(r) : "v"(lo), "v"(hi)); return r; }

__device__ __forceinline__ void stage_rows(int (&sR)[2], int (&sC)[2]) { const int tid = opaque_tid();
#pragma unroll
    for (int i = 0; i < 2; ++i) stage_rc(tid * 16 + i * 8192, sR[i], sC[i]); }
struct StaticOrder {
    int nM, nN, nwg, G, c;
    __device__ void init(int M, int N, int G_, int c_) { nM = M / BM; nN = N / BM; nwg = nM * nN; G = G_; c = c_; }
    __device__ bool next(int i, int& pm, int& pn) const {
        const long L = (long)i * G + c; if (L >= nwg) return false;
        int wgid = (int)L; { const int q = nwg / NXCD, r = nwg % NXCD, xcd = wgid % NXCD, off = wgid / NXCD; wgid = (xcd < r ? xcd * (q + 1) : r * (q + 1) + (xcd - r) * q) + off; }
        const int nig = WGM * nN, gid = wgid / nig, fm = gid * WGM, gsz = (nM - fm) < WGM ? (nM - fm) : WGM;
        pm = fm + ((wgid % nig) % gsz); pn = (wgid % nig) / gsz; return true;
    }
};

template <class P, bool ALIGN_EPI>
__device__ __forceinline__ void gemm_phase(LAS unsigned char* lds, const P& S) {
    const int tid = opaque_tid(), wid = __builtin_amdgcn_readfirstlane(tid >> 6), lane = tid & 63, wr = wid >> 2, wc = wid & 3, fr = lane & 15, fq = lane >> 4;
    constexpr int nt = 16;
    unsigned voffB[2];
#pragma unroll
    for (int i = 0; i < 2; ++i) { int R, C; stage_rc(tid * 16 + i * 8192, R, C); const int Rb = P::PERM ? ((R & ~31) + perm32(R & 31)) : R; voffB[i] = (unsigned)(Rb * P::LDB + C) * 2u; }
    constexpr size_t kstep = (size_t)(BK * 2);
    constexpr size_t hstepB = (size_t)HALF * P::LDB * 2;
    const unsigned ldsw = (unsigned)wid * 1024u;
    const int aoff = lds_byte(wr * 64 + fr, fq * 8), boff = lds_byte(wc * 32 + fr, fq * 8);
#define PG8_SA(b, h) (((b) * 2 + (h)) * HTB)
#define PG8_SB(b, h) ((4 + (b) * 2 + (h)) * HTB)
#define PG8_STAGE(bufoff, gbase, voff) do { _Pragma("unroll") for (int _i = 0; _i < 2; ++_i) \
        __builtin_amdgcn_global_load_lds((const unsigned*)((const char*)(gbase) + (voff)[_i]), (LAS unsigned*)(lds + (bufoff) + ldsw + _i * 8192), 16, 0, 0); } while (0)
#define PG8_LDA(dst, b, h) do { _Pragma("unroll") for (int m = 0; m < 4; ++m) _Pragma("unroll") for (int k = 0; k < 2; ++k) dst[m][k] = *(const LAS bf16x8*)(lds + PG8_SA(b, h) + aoff + m * 2048 + k * 1024); } while (0)
#define PG8_LDB(dst, b, h) do { _Pragma("unroll") for (int n = 0; n < 2; ++n) _Pragma("unroll") for (int k = 0; k < 2; ++k) dst[n][k] = *(const LAS bf16x8*)(lds + PG8_SB(b, h) + boff + n * 2048 + k * 1024); } while (0)
#define PG8_MMA(ai, bj, At, Bt) do { __builtin_amdgcn_s_setprio(1); _Pragma("unroll") for (int m = 0; m < 4; ++m) _Pragma("unroll") for (int n = 0; n < 2; ++n) _Pragma("unroll") for (int k = 0; k < 2; ++k) \
        acc[ai][bj][m][n] = __builtin_amdgcn_mfma_f32_16x16x32_bf16(Bt[n][k], At[m][k], acc[ai][bj][m][n], 0, 0, 0); __builtin_amdgcn_s_setprio(0); } while (0)
#define PG8_WAIT_V(n) asm volatile("s_waitcnt vmcnt(" #n ")" ::: "memory")
#define PG8_WAIT_L(n) asm volatile("s_waitcnt lgkmcnt(" #n ")" ::: "memory")
#define PG8_BAR __builtin_amdgcn_s_barrier()
#define PG8_SCHED __builtin_amdgcn_sched_barrier(0)
    typename P::U cur, nxt; int ui = 0;
    if (!S.next(0, cur)) return;
    f32x4 acc[2][2][4][2];
#pragma unroll
    for (int a = 0; a < 2; ++a)
#pragma unroll
        for (int b = 0; b < 2; ++b)
#pragma unroll
            for (int m = 0; m < 4; ++m)
#pragma unroll
                for (int n = 0; n < 2; ++n) acc[a][b][m][n] = (f32x4){0.f, 0.f, 0.f, 0.f};
    bf16x8 At[4][2], B0[2][2], B1[2][2];
    unsigned offC[2][2];
    S.a_off(cur, offC);
    const char* cA = S.a_base(cur); const char* cB = S.b_base(cur, 0);
    PG8_STAGE(PG8_SB(0, 0), cB, voffB); PG8_STAGE(PG8_SB(0, 1), cB + hstepB, voffB); PG8_STAGE(PG8_SA(0, 0), cA, offC[0]); PG8_STAGE(PG8_SA(0, 1), cA, offC[1]);
    if (wr == 1) PG8_BAR;
    PG8_WAIT_V(2); PG8_BAR;
    PG8_STAGE(PG8_SB(1, 0), cB + kstep, voffB); PG8_STAGE(PG8_SA(1, 0), cA + kstep, offC[0]); PG8_STAGE(PG8_SB(1, 1), cB + hstepB + kstep, voffB);
    PG8_WAIT_V(6); PG8_BAR;
    for (;;) {
        const bool has_next = S.next(ui + 1, nxt);
        const char* nA = cA; const char* nB = cB;
        if (has_next) { nA = S.a_base(nxt); nB = S.b_base(nxt, 0); }
        unsigned o2[2][2];
#pragma nounroll
        for (int t = 0; t < nt; t += 2) {
            const bool last = (t == nt - 2);
            const char* a1 = cA + (size_t)(t + 1) * kstep;
            const char* a2 = last ? nA : cA + (size_t)(t + 2) * kstep; const char* b2 = last ? nB : S.b_base(cur, t + 2);
            const char* a3 = a2 + kstep; const char* b3 = b2 + kstep;
            if (P::GATHER && last && has_next) S.a_off(nxt, o2);
            else {
#pragma unroll
                for (int h = 0; h < 2; ++h)
#pragma unroll
                    for (int i = 0; i < 2; ++i) o2[h][i] = offC[h][i]; }
            PG8_LDB(B0, 0, 0); PG8_LDB(B1, 0, 1); PG8_SCHED; PG8_LDA(At, 0, 0); PG8_STAGE(PG8_SA(1, 1), a1, offC[1]);
            PG8_WAIT_V(8); PG8_WAIT_L(0); PG8_BAR; PG8_MMA(0, 0, At, B0); PG8_MMA(0, 1, At, B1); PG8_BAR; PG8_SCHED;
            PG8_LDA(At, 0, 1); PG8_STAGE(PG8_SB(0, 0), b2, voffB); PG8_STAGE(PG8_SB(0, 1), b2 + hstepB, voffB); PG8_STAGE(PG8_SA(0, 0), a2, o2[0]);
            PG8_WAIT_V(8); PG8_WAIT_L(0); PG8_BAR; PG8_MMA(1, 0, At, B0); PG8_MMA(1, 1, At, B1); PG8_BAR; PG8_SCHED;
            PG8_LDB(B0, 1, 0); PG8_LDB(B1, 1, 1); PG8_SCHED; PG8_LDA(At, 1, 0); PG8_STAGE(PG8_SA(0, 1), a2, o2[1]);
            PG8_WAIT_V(8); PG8_WAIT_L(0); PG8_BAR; PG8_MMA(0, 0, At, B0); PG8_MMA(0, 1, At, B1); PG8_BAR; PG8_SCHED;
            PG8_LDA(At, 1, 1); PG8_STAGE(PG8_SB(1, 0), b3, voffB); PG8_STAGE(PG8_SB(1, 1), b3 + hstepB, voffB); PG8_STAGE(PG8_SA(1, 0), a3, o2[0]);
            PG8_WAIT_V(8); PG8_WAIT_L(0); PG8_BAR; PG8_MMA(1, 0, At, B0); PG8_MMA(1, 1, At, B1); PG8_BAR; PG8_SCHED;
        }
        if constexpr (ALIGN_EPI) { if (wr == 0) PG8_BAR; }
        S.epi(acc, cur, wr, wc, fr, fq);
        if (!has_next) break;
#pragma unroll
        for (int a = 0; a < 2; ++a)
#pragma unroll
            for (int b = 0; b < 2; ++b)
#pragma unroll
                for (int m = 0; m < 4; ++m)
#pragma unroll
                    for (int n = 0; n < 2; ++n) acc[a][b][m][n] = (f32x4){0.f, 0.f, 0.f, 0.f};
        cur = nxt; cA = nA; cB = nB; ++ui;
        if constexpr (P::GATHER) {
#pragma unroll
            for (int h = 0; h < 2; ++h)
#pragma unroll
                for (int i = 0; i < 2; ++i) offC[h][i] = o2[h][i]; }
        if constexpr (ALIGN_EPI) { if (wr == 1) PG8_BAR; }
    }
    PG8_WAIT_V(0);
    if constexpr (!ALIGN_EPI) { if (wr == 0) PG8_BAR; }
    PG8_BAR;
#undef PG8_SA
#undef PG8_SB
#undef PG8_STAGE
#undef PG8_LDA
#undef PG8_LDB
#undef PG8_MMA
#undef PG8_WAIT_V
#undef PG8_WAIT_L
#undef PG8_BAR
#undef PG8_SCHED
}
}

struct Args { const float* in[20]; float* out; unsigned char* ws; int l, pad; };
struct ArgsG { const GAS float* in[20]; float* out; unsigned char* ws; int l, pad; };
typedef __attribute__((address_space(4))) const ArgsG* KArgs;
typedef const GAS float* gin;
struct Frame {
    LAS unsigned char* lds;
    gu32* ctl;
    unsigned char* ws; unsigned char* ws0;
    KArgs ap;
    float* out; float* out0;
    int tid, lane, wave, G, bid;
    __device__ __forceinline__ gin in(int i) const { return ap->in[i]; }
};
__device__ __forceinline__ void rebind(Frame& F) {
    F.tid = opaque_tid(); F.lane = F.tid & 63; F.wave = __builtin_amdgcn_readfirstlane(F.tid >> 6);
    KArgs ap = (KArgs)__builtin_amdgcn_kernarg_segment_ptr(); asm volatile("" : "+s"(ap)); F.ap = ap;
    size_t z = 0; asm volatile("" : "+s"(z));
    F.ws = F.ws0 + z; F.ctl = (gu32*)(F.ws + WS_CTL); F.out = F.out0 + z;
    int g = gridDim.x; asm volatile("" : "+s"(g)); F.G = g;
    int b = blockIdx.x; asm volatile("" : "+s"(b)); F.bid = b;
}
enum { I_X = 0, I_C, I_WADA, I_BADA, I_WIN, I_BG, I_MHW, I_WCONV, I_WOUT, I_LN1G, I_LN1B, I_WGRP, I_BGRP, I_WR, I_BR, I_WGATE, I_WUP, I_WDOWN, I_LN2G, I_LN2B };

struct UnitS { int pm, pn; };
struct PolInProj {
    typedef UnitS U; static constexpr bool PERM = true, GATHER = false; static constexpr int LDB = 1024;
    pg8::StaticOrder so; const char* A; const char* B; bf16* O;
    __device__ __forceinline__ bool next(int i, U& u) const { return so.next(i, u.pm, u.pn); }
    __device__ __forceinline__ const char* a_base(const U& u) const { return A + (size_t)u.pm * (256 * 2048); }
    __device__ __forceinline__ void a_off(const U&, unsigned (&o)[2][2]) const { int sR[2], sC[2]; pg8::stage_rows(sR, sC);
#pragma unroll
        for (int h = 0; h < 2; ++h)
#pragma unroll
            for (int i = 0; i < 2; ++i) o[h][i] = (unsigned)((h * 128 + sR[i]) * 1024 + sC[i]) * 2u; }
    __device__ __forceinline__ const char* b_base(const U& u, int kt) const { return B + (size_t)u.pn * (256 * 2048) + (size_t)kt * 128; }
    __device__ __forceinline__ void epi(const f32x4 (&acc)[2][2][4][2], const U& u, int wr, int wc, int fr, int fq) const {
        const int row0 = u.pm * 256 + wr * 64 + fr, col0 = u.pn * 256 + wc * 32 + 8 * fq;
#pragma unroll
        for (int ai = 0; ai < 2; ++ai)
#pragma unroll
            for (int m = 0; m < 4; ++m) { bf16* rowp = O + (size_t)(row0 + ai * 128 + m * 16) * DINW + col0;
#pragma unroll
                for (int bj = 0; bj < 2; ++bj) { const f32x4 v0 = acc[ai][bj][m][0], v1 = acc[ai][bj][m][1];
                    u32x4 w; w.x = pg8::cvt_pk_bf16(v0[0], v0[1]); w.y = pg8::cvt_pk_bf16(v0[2], v0[3]); w.z = pg8::cvt_pk_bf16(v1[0], v1[1]); w.w = pg8::cvt_pk_bf16(v1[2], v1[3]);
                    *(u32x4*)(rowp + bj * 128) = w; } }
    }
};
struct PolOutProj {
    typedef UnitS U; static constexpr bool PERM = false, GATHER = false; static constexpr int LDB = 1024;
    pg8::StaticOrder so; const char* A; const char* B; float* C;
    __device__ __forceinline__ bool next(int i, U& u) const { return so.next(i, u.pm, u.pn); }
    __device__ __forceinline__ const char* a_base(const U& u) const { return A + (size_t)u.pm * (256 * 2048); }
    __device__ __forceinline__ void a_off(const U&, unsigned (&o)[2][2]) const { int sR[2], sC[2]; pg8::stage_rows(sR, sC);
#pragma unroll
        for (int h = 0; h < 2; ++h)
#pragma unroll
            for (int i = 0; i < 2; ++i) o[h][i] = (unsigned)((h * 128 + sR[i]) * 1024 + sC[i]) * 2u; }
    __device__ __forceinline__ const char* b_base(const U& u, int kt) const { return B + (size_t)u.pn * (256 * 2048) + (size_t)kt * 128; }
    __device__ __forceinline__ void epi(const f32x4 (&acc)[2][2][4][2], const U& u, int wr, int wc, int fr, int fq) const {
        const int row0 = u.pm * 256 + wr * 64 + fr, col0 = u.pn * 256 + wc * 32 + 4 * fq;
#pragma unroll
        for (int ai = 0; ai < 2; ++ai)
#pragma unroll
            for (int m = 0; m < 4; ++m) { float* rowp = C + (size_t)(row0 + ai * 128 + m * 16) * D + col0;
#pragma unroll
                for (int bj = 0; bj < 2; ++bj)
#pragma unroll
                    for (int n = 0; n < 2; ++n) *(f32x4*)(rowp + bj * 128 + n * 16) = acc[ai][bj][m][n]; }
    }
};
struct UnitM { int tile, pn, cls, tb, cnt; };
__device__ __forceinline__ int pair_a(int p) { return p < 3 ? 0 : (p < 5 ? 1 : 2); }
__device__ __forceinline__ int pair_b(int p) { return p < 3 ? p + 1 : (p < 5 ? p - 1 : 3); }
struct PolMoeGU {
    typedef UnitM U; static constexpr bool PERM = true, GATHER = true; static constexpr int LDB = 1024;
    const LAS int* tcls; const LAS int* ttb; const LAS int* cnts; int NT, G, c;
    const char* A; const char* B  ; const RInfo* ri; bf16* H;
    __device__ __forceinline__ bool next(int i, U& u) const { const int L = i * G + c; const int tile = L >> 3; if (tile >= NT) return false;
        u.tile = tile; u.pn = L & 7; u.cls = tcls[tile]; u.tb = ttb[tile]; u.cnt = cnts[u.cls]; return true; }
    __device__ __forceinline__ const char* a_base(const U&) const { return A; }
    __device__ __forceinline__ void a_off(const U& u, unsigned (&o)[2][2]) const { int sR[2], sC[2]; pg8::stage_rows(sR, sC);
#pragma unroll
        for (int h = 0; h < 2; ++h)
#pragma unroll
            for (int i = 0; i < 2; ++i) { int rr = u.tb + h * 128 + sR[i]; if (rr >= u.cnt) rr = 0; const int tok = ri[(size_t)u.cls * CLS_CAP + rr].token; o[h][i] = (unsigned)tok * 2048u + (unsigned)sC[i] * 2u; } }
    __device__ __forceinline__ const char* b_base(const U& u, int kt) const { const int g = u.cls / 6, p = u.cls - g * 6, e = (u.pn >> 2) ? pair_b(p) : pair_a(p);
        return B + ((size_t)(g * 4 + e) * 1024 + (size_t)(u.pn & 3) * 256) * 2048 + (size_t)kt * 128; }
    __device__ __forceinline__ void epi(const f32x4 (&acc)[2][2][4][2], const U& u, int wr, int wc, int fr, int fq) const {
        const int slot = u.pn >> 2, ct = u.pn & 3;
#pragma unroll
        for (int ai = 0; ai < 2; ++ai)
#pragma unroll
            for (int m = 0; m < 4; ++m) { const int r = ai * 128 + wr * 64 + m * 16 + fr, rr = u.tb + r; const bool valid = rr < u.cnt;
                float w = 0.f; if (valid) { const RInfo* q = ri + (size_t)u.cls * CLS_CAP + rr; w = slot ? q->wb : q->wa; }
                float hv[8];
#pragma unroll
                for (int n = 0; n < 2; ++n)
#pragma unroll
                    for (int j = 0; j < 4; ++j) { const float g = acc[ai][0][m][n][j], up = acc[ai][1][m][n][j]; hv[n * 4 + j] = g * __builtin_amdgcn_rcpf(1.0f + __expf(-g)) * up * w; }
                u32x4 o; o.x = pg8::cvt_pk_bf16(hv[0], hv[1]); o.y = pg8::cvt_pk_bf16(hv[2], hv[3]); o.z = pg8::cvt_pk_bf16(hv[4], hv[5]); o.w = pg8::cvt_pk_bf16(hv[6], hv[7]);
                if (valid) *(u32x4*)(H + (size_t)(u.tile * 256 + r) * 1024 + slot * 512 + ct * 128 + wc * 32 + 8 * fq) = o; }
    }
};
struct PolMoeDown {
    typedef UnitM U; static constexpr bool PERM = true, GATHER = false; static constexpr int LDB = 512;
    const LAS int* tcls; const LAS int* ttb; const LAS int* cnts; int NT, G, c;
    const char* A  ; const char* B  ; const RInfo* ri; bf16* Y;
    __device__ __forceinline__ bool next(int i, U& u) const { const int L = i * G + c; const int tile = L >> 2; if (tile >= NT) return false;
        u.tile = tile; u.pn = L & 3; u.cls = tcls[tile]; u.tb = ttb[tile]; u.cnt = cnts[u.cls]; return true; }
    __device__ __forceinline__ const char* a_base(const U& u) const { return A + (size_t)u.tile * (256 * 2048); }
    __device__ __forceinline__ void a_off(const U&, unsigned (&o)[2][2]) const { int sR[2], sC[2]; pg8::stage_rows(sR, sC);
#pragma unroll
        for (int h = 0; h < 2; ++h)
#pragma unroll
            for (int i = 0; i < 2; ++i) o[h][i] = (unsigned)((h * 128 + sR[i]) * 1024 + sC[i]) * 2u; }
    __device__ __forceinline__ const char* b_base(const U& u, int kt) const { const int g = u.cls / 6, p = u.cls - g * 6, e = (kt >> 3) ? pair_b(p) : pair_a(p);
        return B + ((size_t)(g * 4 + e) * 1024 + (size_t)u.pn * 256) * 1024 + (size_t)(kt & 7) * 128; }
    __device__ __forceinline__ void epi(const f32x4 (&acc)[2][2][4][2], const U& u, int wr, int wc, int fr, int fq) const {
#pragma unroll
        for (int ai = 0; ai < 2; ++ai)
#pragma unroll
            for (int m = 0; m < 4; ++m) { const int r = ai * 128 + wr * 64 + m * 16 + fr, rr = u.tb + r; const bool valid = rr < u.cnt;
                if (valid) { const int tok = ri[(size_t)u.cls * CLS_CAP + rr].token; bf16* rowp = Y + (size_t)tok * D + u.pn * 256 + wc * 32 + 8 * fq;
#pragma unroll
                    for (int bj = 0; bj < 2; ++bj) { const f32x4 v0 = acc[ai][bj][m][0], v1 = acc[ai][bj][m][1];
                        u32x4 w; w.x = pg8::cvt_pk_bf16(v0[0], v0[1]); w.y = pg8::cvt_pk_bf16(v0[2], v0[3]); w.z = pg8::cvt_pk_bf16(v1[0], v1[1]); w.w = pg8::cvt_pk_bf16(v1[2], v1[3]);
                        *(u32x4*)(rowp + bj * 128) = w; } } }
    }
};

__device__ __forceinline__ void transpose_item(gin W, int ldw, int k0, int n0, bf16* WT, int ldk, int drow0, float scale, LAS float* scr, int lane) {
#pragma unroll 8
    for (int i = 0; i < 32; ++i) { const int kk = 2 * i + (lane >> 5); scr[kk * 33 + (lane & 31)] = W[(size_t)(k0 + kk) * ldw + n0 + (lane & 31)]; }
    LDS_WAIT(); asm volatile("" ::: "memory");
    const int c = lane & 7;
#pragma unroll
    for (int j = 0; j < 4; ++j) { const int n = (lane >> 3) + 8 * j; const LAS float* s = scr + (8 * c) * 33 + n;
        u32x4 o; o.x = pk2(s[0 * 33] * scale, s[1 * 33] * scale); o.y = pk2(s[2 * 33] * scale, s[3 * 33] * scale); o.z = pk2(s[4 * 33] * scale, s[5 * 33] * scale); o.w = pk2(s[6 * 33] * scale, s[7 * 33] * scale);
        *(u32x4*)(WT + (size_t)(drow0 + n) * ldk + k0 + 8 * c) = o; }
    LDS_WAIT(); asm volatile("" ::: "memory");
}
__device__ __forceinline__ void phase_prologue(Frame& F) {
    rebind(F);
    {
        LAS float* scr = (LAS float*)(F.lds + F.wave * 16384);
        const int gw = F.bid * NWAVES + F.wave, NGW = F.G * NWAVES;
        constexpr int I_IN = NL * 16 * 112, I_OUT = NL * 16 * 32, I_G = NL * 16 * 256, I_DN = NL * 16 * 256;
        constexpr int NITEMS = I_IN + I_OUT + 2 * I_G + I_DN;
        for (int it = gw; it < NITEMS; it += NGW) {
            int r = it;
            if (r < I_IN) { const int l = r / 1792, q = r % 1792, kb = q / 112, nb = q % 112, nd = nb * 32, ns = nd < 2048 ? nd : nd + 8;
                transpose_item(F.in(I_WIN) + (size_t)l * D * DIN_SRC, DIN_SRC, kb * 64, ns, (bf16*)(F.ws + WS_WIN) + (size_t)l * DINW * D, D, nd, nd < 512 ? QSCALE : 1.0f, scr, F.lane); continue; }
            r -= I_IN;
            if (r < I_OUT) { const int l = r / 512, q = r % 512, kb = q / 32, nb = q % 32;
                transpose_item(F.in(I_WOUT) + (size_t)l * D * D, D, kb * 64, nb * 32, (bf16*)(F.ws + WS_WOUT) + (size_t)l * D * D, D, nb * 32, 1.0f, scr, F.lane); continue; }
            r -= I_OUT;
            if (r < 2 * I_G) { const int up = r >= I_G; if (up) r -= I_G; const int mat = r / 256, q = r % 256, kb = q / 16, nb = q % 16, f0 = nb * 32;
                transpose_item(F.in(up ? I_WUP : I_WGATE) + (size_t)mat * D * 512, 512, kb * 64, f0, (bf16*)(F.ws + WS_WGU) + (size_t)mat * 1024 * 1024, 1024, (f0 >> 7) * 256 + (f0 & 127) + (up ? 128 : 0), 1.0f, scr, F.lane); continue; }
            r -= 2 * I_G;
            { const int mat = r / 256, q = r % 256, kb = q / 32, nb = q % 32;
                transpose_item(F.in(I_WDOWN) + (size_t)mat * 512 * D, D, kb * 64, nb * 32, (bf16*)(F.ws + WS_WD) + (size_t)mat * 1024 * 512, 512, nb * 32, 1.0f, scr, F.lane); }
        }
    }
    __syncthreads();
    {
        LAS float* cond = (LAS float*)F.lds;
        LAS float* red = (LAS float*)(F.lds + 65536);
        bool have = false;
        for (int un = F.bid; un < NL * 192; un += F.G) {
            if (!have) { for (int i = F.tid; i < 16 * 1024; i += NTHR) { const float c = F.in(I_C)[i]; cond[i] = c * sigmoidf_(c); } have = true; }
            __syncthreads();
            const int l = un / 192, n0 = (un % 192) * 32, n = F.tid & 31, ks = F.tid >> 5;
            gin W = F.in(I_WADA) + (size_t)l * D * 6144 + n0 + n;
            float acc[16];
#pragma unroll
            for (int b = 0; b < 16; ++b) acc[b] = 0.f;
            for (int kk = 0; kk < 64; ++kk) { const int k = ks * 64 + kk; const float w = W[(size_t)k * 6144];
#pragma unroll
                for (int b = 0; b < 16; ++b) acc[b] += cond[b * 1024 + k] * w; }
#pragma unroll
            for (int b = 0; b < 16; ++b) red[(ks * 16 + b) * 32 + n] = acc[b];
            __syncthreads();
            { const int b = F.tid >> 5; float s = 0.f;
#pragma unroll
              for (int k2 = 0; k2 < 16; ++k2) s += red[(k2 * 16 + b) * 32 + n];
              ((float*)(F.ws + WS_MOD))[((size_t)l * 16 + b) * 6144 + n0 + n] = s + F.in(I_BADA)[l * 6144 + n0 + n]; }
        }
    }
}

__device__ __forceinline__ void stage_cols_T(LAS float* dst, gin src, int ld, int col0, int NC, int tid) {
    for (int idx = tid; idx < NC * 1024; idx += NTHR) { const int k = idx / NC, c = idx - k * NC; dst[c * 1024 + k] = src[(size_t)k * ld + col0 + c]; }
}
__device__ __forceinline__ void modulate_gates(Frame& F, const f32x4 (&xo)[4], int m, int lg, const LAS float* wgT) {
    const float* mod = (const float*)(F.ws + WS_MOD) + ((size_t)lg * 16 + (m >> 11)) * 6144;
    f32x4 u[4];
#pragma unroll
    for (int j = 0; j < 4; ++j) { const int col = 256 * j + 4 * F.lane; const f32x4 sh = *(const f32x4*)(mod + col), sc = *(const f32x4*)(mod + 1024 + col); u[j] = xo[j] * (1.0f + sc) + sh; }
    bf16* up = (bf16*)(F.ws + WS_UA) + (size_t)m * D;
#pragma unroll
    for (int j = 0; j < 4; ++j) { u32x2 w; w.x = pk2(u[j][0], u[j][1]); w.y = pk2(u[j][2], u[j][3]); *(u32x2*)(up + 256 * j + 4 * F.lane) = w; }
    float g[8];
#pragma unroll
    for (int c = 0; c < 8; ++c) { float s = 0.f;
#pragma unroll
        for (int j = 0; j < 4; ++j) { const f32x4 w = *(const LAS f32x4*)(wgT + c * 1024 + 256 * j + 4 * F.lane); s += (u[j][0] * w[0] + u[j][1] * w[1]) + (u[j][2] * w[2] + u[j][3] * w[3]); }
        g[c] = wave_sum(s); }
    float val = g[0];
#pragma unroll
    for (int c = 1; c < 8; ++c) val = (F.lane == c) ? g[c] : val;
    if (F.lane < 8) ((float*)(F.ws + WS_GATES))[(size_t)m * 8 + F.lane] = val + F.in(I_BG)[lg * 8 + F.lane];
}
__device__ __forceinline__ void ln_row(f32x4 (&z)[4], gin g, gin b, int lane) {
    float s = 0.f;
#pragma unroll
    for (int j = 0; j < 4; ++j) s += (z[j][0] + z[j][1]) + (z[j][2] + z[j][3]);
    const float mean = wave_sum(s) * (1.0f / D); float q = 0.f;
#pragma unroll
    for (int j = 0; j < 4; ++j) { z[j] = z[j] - mean; q += (z[j][0] * z[j][0] + z[j][1] * z[j][1]) + (z[j][2] * z[j][2] + z[j][3] * z[j][3]); }
    const float rstd = 1.0f / sqrtf(wave_sum(q) * (1.0f / D) + LN_EPS);
#pragma unroll
    for (int j = 0; j < 4; ++j) { const int col = 256 * j + 4 * lane; const f32x4 gg = *(const GAS f32x4*)(g + col), bb = *(const GAS f32x4*)(b + col); z[j] = z[j] * rstd * gg + bb; }
}
__device__ __forceinline__ void phase_rowA(Frame& F) {
    rebind(F);
    LAS float* wgT = (LAS float*)(F.lds + 81920);
    stage_cols_T(wgT, F.in(I_WIN), DIN_SRC, 2048, 8, F.tid);
    __syncthreads();
    const int gw = F.bid * NWAVES + F.wave, NGW = F.G * NWAVES;
    for (int m = gw; m < T; m += NGW) {
        f32x4 x[4];
#pragma unroll
        for (int j = 0; j < 4; ++j) x[j] = *(const GAS f32x4*)(F.in(I_X) + (size_t)m * D + 256 * j + 4 * F.lane);
        modulate_gates(F, x, m, 0, wgT);
    }
}
__device__ __forceinline__ void phase_rowB(Frame& F, int l) {
    rebind(F);
    LAS float* wrT = (LAS float*)F.lds;
    LAS int* lcnt = (LAS int*)(F.lds + MISC_OFF + MO_LCNT);
    LAS int* lbase = (LAS int*)(F.lds + MISC_OFF + MO_LBASE);
    LAS int* rec = (LAS int*)(F.lds + MISC_OFF + MO_REC);
    stage_cols_T(wrT, F.in(I_WGRP) + (size_t)l * D * 4, 4, 0, 4, F.tid);
    stage_cols_T(wrT + 4 * 1024, F.in(I_WR) + (size_t)l * D * 16, 16, 0, 16, F.tid);
    if (F.tid < NCLS) lcnt[F.tid] = 0;
    __syncthreads();
    gin xcur = (l == 0) ? F.in(I_X) : (gin)F.out;
    const float* mix = (const float*)(F.ws + WS_BIG);
    float* x1p = (float*)(F.ws + WS_X1);
    RInfo* ri = (RInfo*)(F.ws + WS_RINFO);
    for (int rb = F.bid; rb < T / 128; rb += F.G) {
        for (int rl = F.wave; rl < 128; rl += NWAVES) {
            const int m = rb * 128 + rl;
            const float* mod = (const float*)(F.ws + WS_MOD) + ((size_t)l * 16 + (m >> 11)) * 6144;
            f32x4 z[4];
#pragma unroll
            for (int j = 0; j < 4; ++j) { const int col = 256 * j + 4 * F.lane; const f32x4 xv = *(const GAS f32x4*)(xcur + (size_t)m * D + col), mv = *(const f32x4*)(mix + (size_t)m * D + col), gt = *(const f32x4*)(mod + 2048 + col);
                z[j] = xv * ALPHA + (1.0f + gt) * mv; }
            ln_row(z, F.in(I_LN1G) + l * D, F.in(I_LN1B) + l * D, F.lane);
            f32x4 u[4];
#pragma unroll
            for (int j = 0; j < 4; ++j) { const int col = 256 * j + 4 * F.lane; *(f32x4*)(x1p + (size_t)m * D + col) = z[j];
                const f32x4 sh = *(const f32x4*)(mod + 3072 + col), sc = *(const f32x4*)(mod + 4096 + col); u[j] = z[j] * (1.0f + sc) + sh; }
            bf16* up = (bf16*)(F.ws + WS_UA) + (size_t)m * D;
#pragma unroll
            for (int j = 0; j < 4; ++j) { u32x2 w; w.x = pk2(u[j][0], u[j][1]); w.y = pk2(u[j][2], u[j][3]); *(u32x2*)(up + 256 * j + 4 * F.lane) = w; }
            float lg[20];
#pragma unroll
            for (int c = 0; c < 20; ++c) { float s = 0.f;
#pragma unroll
                for (int j = 0; j < 4; ++j) { const f32x4 w = *(const LAS f32x4*)(wrT + c * 1024 + 256 * j + 4 * F.lane); s += (u[j][0] * w[0] + u[j][1] * w[1]) + (u[j][2] * w[2] + u[j][3] * w[3]); }
                lg[c] = wave_sum(s); }
            float gl[4];
#pragma unroll
            for (int j = 0; j < 4; ++j) gl[j] = lg[j] + F.in(I_BGRP)[l * 4 + j];
            int gi = 0; float gm = gl[0];
#pragma unroll
            for (int j = 1; j < 4; ++j) if (gl[j] > gm) { gm = gl[j]; gi = j; }
            float den = 0.f;
#pragma unroll
            for (int j = 0; j < 4; ++j) den += __expf(gl[j] - gm);
            const float grp_w = 1.0f / den;
            float el[4];
#pragma unroll
            for (int e = 0; e < 4; ++e) { float v = lg[4 + e];
#pragma unroll
                for (int g2 = 1; g2 < 4; ++g2) v = (gi == g2) ? lg[4 + g2 * 4 + e] : v;
                el[e] = v + F.in(I_BR)[l * 16 + gi * 4 + e]; }
            int i1 = 0; float v1 = el[0];
#pragma unroll
            for (int e = 1; e < 4; ++e) if (el[e] > v1) { v1 = el[e]; i1 = e; }
            int i2 = -1; float v2 = -3.0e38f;
#pragma unroll
            for (int e = 0; e < 4; ++e) if (e != i1 && el[e] > v2) { v2 = el[e]; i2 = e; }
            const float ex = __expf(v2 - v1), w1 = grp_w / (1.0f + ex), w2 = grp_w * ex / (1.0f + ex);
            const int ea = i1 < i2 ? i1 : i2, eb = i1 < i2 ? i2 : i1; const float wa = i1 < i2 ? w1 : w2, wb = i1 < i2 ? w2 : w1;
            const int p = ea == 0 ? eb - 1 : (ea == 1 ? eb + 1 : 5), cls = gi * 6 + p;
            if (F.lane == 0) { const int lr = __hip_atomic_fetch_add(lcnt + cls, 1, __ATOMIC_RELAXED, __HIP_MEMORY_SCOPE_WORKGROUP);
                rec[rl * 4 + 0] = cls; rec[rl * 4 + 1] = lr; rec[rl * 4 + 2] = __builtin_bit_cast(int, wa); rec[rl * 4 + 3] = __builtin_bit_cast(int, wb); }
        }
        __syncthreads();
        if (F.tid < NCLS) { const int n = lcnt[F.tid]; lbase[F.tid] = n ? (int)__hip_atomic_fetch_add(F.ctl + CW_CNT + l * 32 + F.tid, (unsigned)n, RLX_AGENT) : 0; }
        __syncthreads();
        if (F.tid < 128) { const int cls = rec[F.tid * 4], pos = lbase[cls] + rec[F.tid * 4 + 1];
            RInfo r; r.token = rb * 128 + F.tid; r.wa = __builtin_bit_cast(float, rec[F.tid * 4 + 2]); r.wb = __builtin_bit_cast(float, rec[F.tid * 4 + 3]); r.pad = 0;
            ri[(size_t)cls * CLS_CAP + pos] = r; }
        __syncthreads();
        if (F.tid < NCLS) lcnt[F.tid] = 0;
        __syncthreads();
    }
}
__device__ __forceinline__ void phase_rowC(Frame& F, int l) {
    rebind(F);
    LAS float* wgT = (LAS float*)(F.lds + 81920);
    if (l + 1 < NL) stage_cols_T(wgT, F.in(I_WIN) + (size_t)(l + 1) * D * DIN_SRC, DIN_SRC, 2048, 8, F.tid);
    __syncthreads();
    const float* x1p = (const float*)(F.ws + WS_X1); const bf16* yp = (const bf16*)(F.ws + WS_Y);
    const int gw = F.bid * NWAVES + F.wave, NGW = F.G * NWAVES;
    for (int m = gw; m < T; m += NGW) {
        const float* mod = (const float*)(F.ws + WS_MOD) + ((size_t)l * 16 + (m >> 11)) * 6144;
        f32x4 z[4];
#pragma unroll
        for (int j = 0; j < 4; ++j) { const int col = 256 * j + 4 * F.lane; const f32x4 xv = *(const f32x4*)(x1p + (size_t)m * D + col), gt = *(const f32x4*)(mod + 5120 + col); const u32x2 yw = *(const u32x2*)(yp + (size_t)m * D + col);
            const f32x4 yv = (f32x4){bf_lo(yw.x), bf_hi(yw.x), bf_lo(yw.y), bf_hi(yw.y)};
            z[j] = xv * ALPHA + (1.0f + gt) * yv; }
        ln_row(z, F.in(I_LN2G) + l * D, F.in(I_LN2B) + l * D, F.lane);
#pragma unroll
        for (int j = 0; j < 4; ++j) *(f32x4*)(F.out + (size_t)m * D + 256 * j + 4 * F.lane) = z[j];
        if (l + 1 < NL) modulate_gates(F, z, m, l + 1, wgT);
    }
}

__device__ __forceinline__ void mlstm_naive_unit(Frame& F, int l, int bh) {
    const int b = bh >> 2, h = bh & 3, tid = F.tid, v = tid >> 2, kp = tid & 3;
    LAS float* Qs = (LAS float*)F.lds; LAS float* Ks = Qs + 64 * 128; LAS float* Vs = Ks + 64 * 128; LAS float* Hb = Vs + 64 * 128;
    LAS float* sg = (LAS float*)(F.lds + MISC_OFF + MO_SG);
    const bf16* proj = (const bf16*)(F.ws + WS_BIG); const float* gates = (const float*)(F.ws + WS_GATES);
    bf16* outp = (bf16*)(F.ws + WS_UA);
    float C[32], nn[32];
#pragma unroll
    for (int j = 0; j < 32; ++j) { C[j] = 0.f; nn[j] = 0.f; }
    float mst = 0.f;
    for (int blk = 0; blk < SEQ / 64; ++blk) {
        const int tok0 = b * SEQ + blk * 64;
#pragma unroll
        for (int i = 0; i < 2; ++i) { const int idx = tid + i * NTHR, row = idx >> 4, c8 = idx & 15; const bf16* p = proj + (size_t)(tok0 + row) * DINW + h * 128 + c8 * 8;
            const u32x4 q = *(const u32x4*)p, k = *(const u32x4*)(p + 512), vv = *(const u32x4*)(p + 1024);
            LAS float* dq = Qs + row * 128 + c8 * 8; LAS float* dk = Ks + row * 128 + c8 * 8; LAS float* dv = Vs + row * 128 + c8 * 8;
#pragma unroll
            for (int e = 0; e < 4; ++e) { dq[2 * e] = bf_lo(q[e]); dq[2 * e + 1] = bf_hi(q[e]); dk[2 * e] = bf_lo(k[e]); dk[2 * e + 1] = bf_hi(k[e]); dv[2 * e] = bf_lo(vv[e]); dv[2 * e + 1] = bf_hi(vv[e]); } }
        if (tid < 64) { const float ip = gates[(size_t)(tok0 + tid) * 8 + h], fp = gates[(size_t)(tok0 + tid) * 8 + 4 + h];
            const float lf = fminf(fp, 0.f) - log1pf(__expf(-fabsf(fp)));
            sg[tid * 2] = lf; sg[tid * 2 + 1] = ip; }
        __syncthreads();
        for (int t = 0; t < 64; ++t) {
            const float lf = sg[t * 2], ig = sg[t * 2 + 1];
            const float mnew = fmaxf(lf + mst, ig), fd = __expf(lf + mst - mnew), ii = __expf(ig - mnew); mst = mnew;
            const float vv = Vs[t * 128 + v] * ii;
            float hp = 0.f, dp = 0.f;
#pragma unroll
            for (int j4 = 0; j4 < 8; ++j4) { const f32x4 kk = *(const LAS f32x4*)(Ks + t * 128 + kp * 32 + j4 * 4), qq = *(const LAS f32x4*)(Qs + t * 128 + kp * 32 + j4 * 4);
#pragma unroll
                for (int e = 0; e < 4; ++e) { const int j = j4 * 4 + e; C[j] = fd * C[j] + vv * kk[e]; nn[j] = fd * nn[j] + ii * kk[e]; hp += C[j] * qq[e]; dp += nn[j] * qq[e]; } }
            hp += __shfl_xor(hp, 1); hp += __shfl_xor(hp, 2); dp += __shfl_xor(dp, 1); dp += __shfl_xor(dp, 2);
            const float hv = hp / fmaxf(fabsf(dp), __expf(-mst));
            if (kp == 0) Hb[t * 128 + v] = hv;
        }
        __syncthreads();
        { const int t = tid >> 3, part = tid & 7; float x[16]; float s = 0.f;
#pragma unroll
          for (int j = 0; j < 16; ++j) { x[j] = Hb[t * 128 + part * 16 + j]; s += x[j]; }
          s += __shfl_xor(s, 1); s += __shfl_xor(s, 2); s += __shfl_xor(s, 4);
          const float mean = s * (1.0f / 128.0f); float q = 0.f;
#pragma unroll
          for (int j = 0; j < 16; ++j) { x[j] -= mean; q += x[j] * x[j]; }
          q += __shfl_xor(q, 1); q += __shfl_xor(q, 2); q += __shfl_xor(q, 4);
          const float rstd = 1.0f / sqrtf(q * (1.0f / 128.0f) + LN_EPS);
          const bf16* op = proj + (size_t)(tok0 + t) * DINW + 1536 + h * 128 + part * 16; gin wn = F.in(I_MHW) + l * 512 + h * 128 + part * 16;
          const u32x4 o0 = *(const u32x4*)op, o1 = *(const u32x4*)(op + 8);
          float r[16];
#pragma unroll
          for (int e = 0; e < 4; ++e) { r[2 * e] = bf_lo(o0[e]); r[2 * e + 1] = bf_hi(o0[e]); r[8 + 2 * e] = bf_lo(o1[e]); r[8 + 2 * e + 1] = bf_hi(o1[e]); }
#pragma unroll
          for (int j = 0; j < 16; ++j) r[j] = x[j] * rstd * wn[j] * sigmoidf_(r[j]);
          u32x4 w0, w1;
#pragma unroll
          for (int e = 0; e < 4; ++e) { w0[e] = pk2(r[2 * e], r[2 * e + 1]); w1[e] = pk2(r[8 + 2 * e], r[8 + 2 * e + 1]); }
          bf16* dp2 = outp + (size_t)(tok0 + t) * D + h * 128 + part * 16; *(u32x4*)dp2 = w0; *(u32x4*)(dp2 + 8) = w1; }
        __syncthreads();
    }
}
__device__ __forceinline__ void conv_items(Frame& F, int l, int first_block, int nblocks) {
    const bf16* proj = (const bf16*)(F.ws + WS_BIG); bf16* outp = (bf16*)(F.ws + WS_UA);
    const int nthreads = nblocks * NTHR;
    for (int id = (F.bid - first_block) * NTHR + F.tid; id < (T / 32) * 64; id += nthreads) {
        const int cg = id & 63, run = id >> 6, t0 = run * 32, c0 = cg * 8;
        float w[3][8];
#pragma unroll
        for (int j = 0; j < 3; ++j)
#pragma unroll
            for (int e = 0; e < 8; ++e) w[j][e] = F.in(I_WCONV)[(size_t)l * 3 * 512 + j * 512 + c0 + e];
        float z1[8], z2[8];
#pragma unroll
        for (int e = 0; e < 8; ++e) { z1[e] = 0.f; z2[e] = 0.f; }
        if ((t0 & (SEQ - 1)) != 0) {
#pragma unroll
            for (int back = 1; back <= 2; ++back) { const bf16* p = proj + (size_t)(t0 - back) * DINW + 2560 + c0; const u32x4 cc = *(const u32x4*)p, ch = *(const u32x4*)(p + 512);
#pragma unroll
                for (int e = 0; e < 4; ++e) { const float a = bf_lo(cc[e]) * bf_lo(ch[e]), b2 = bf_hi(cc[e]) * bf_hi(ch[e]); if (back == 1) { z1[2 * e] = a; z1[2 * e + 1] = b2; } else { z2[2 * e] = a; z2[2 * e + 1] = b2; } } }
        }
        for (int t = t0; t < t0 + 32; ++t) { const bf16* p = proj + (size_t)t * DINW + 2048 + c0; const u32x4 cb = *(const u32x4*)p, cc = *(const u32x4*)(p + 512), ch = *(const u32x4*)(p + 1024);
            float z0[8], y[8];
#pragma unroll
            for (int e = 0; e < 4; ++e) { z0[2 * e] = bf_lo(cc[e]) * bf_lo(ch[e]); z0[2 * e + 1] = bf_hi(cc[e]) * bf_hi(ch[e]); }
#pragma unroll
            for (int e = 0; e < 4; ++e) { y[2 * e] = bf_lo(cb[e]) * (w[0][2 * e] * z2[2 * e] + w[1][2 * e] * z1[2 * e] + w[2][2 * e] * z0[2 * e]);
                y[2 * e + 1] = bf_hi(cb[e]) * (w[0][2 * e + 1] * z2[2 * e + 1] + w[1][2 * e + 1] * z1[2 * e + 1] + w[2][2 * e + 1] * z0[2 * e + 1]); }
            u32x4 o;
#pragma unroll
            for (int e = 0; e < 4; ++e) o[e] = pk2(y[2 * e], y[2 * e + 1]);
            *(u32x4*)(outp + (size_t)t * D + 512 + c0) = o;
#pragma unroll
            for (int e = 0; e < 8; ++e) { z2[e] = z1[e]; z1[e] = z0[e]; } }
    }
}
__device__ __forceinline__ void phase_mixer(Frame& F, int l) {
    rebind(F);
    const int nm = F.G > 64 ? 64 : 0;
    if (nm) { if (F.bid < 64) mlstm_naive_unit(F, l, F.bid); else conv_items(F, l, 64, F.G - 64); }
    else { for (int u = F.bid; u < 64; u += F.G) mlstm_naive_unit(F, l, u); conv_items(F, l, 0, F.G); }
}

__device__ __forceinline__ int moe_tables(Frame& F, int l) {
    LAS int* tcls = (LAS int*)(F.lds + MISC_OFF + MO_TCLS); LAS int* ttb = (LAS int*)(F.lds + MISC_OFF + MO_TTB); LAS int* cnts = (LAS int*)(F.lds + MISC_OFF + MO_CNT); LAS int* ntp = (LAS int*)(F.lds + MISC_OFF + MO_NT);
    __syncthreads();
    if (F.tid == 0) { int t = 0;
        for (int c = 0; c < NCLS; ++c) { int n = (int)__hip_atomic_load(F.ctl + CW_CNT + l * 32 + c, RLX_AGENT); if (n > CLS_CAP) n = CLS_CAP; cnts[c] = n;
            for (int j = 0; j * 256 < n && t < MAXTILES; ++j) { tcls[t] = c; ttb[t] = j * 256; ++t; } }
        ntp[0] = t; }
    __syncthreads();
    return ntp[0];
}
__device__ __forceinline__ void phase_moe_gu(Frame& F, int l) {
    rebind(F);
    const int NT = moe_tables(F, l);
    PolMoeGU P; P.tcls = (const LAS int*)(F.lds + MISC_OFF + MO_TCLS); P.ttb = (const LAS int*)(F.lds + MISC_OFF + MO_TTB); P.cnts = (const LAS int*)(F.lds + MISC_OFF + MO_CNT);
    P.NT = NT; P.G = F.G; P.c = F.bid; P.A = (const char*)(F.ws + WS_UA); P.B = (const char*)(F.ws + WS_WGU) + (size_t)l * 16 * 1024 * 2048; P.ri = (const RInfo*)(F.ws + WS_RINFO); P.H = (bf16*)(F.ws + WS_BIG);
    pg8::gemm_phase<PolMoeGU, true>(F.lds, P);
}
__device__ __forceinline__ void phase_moe_down(Frame& F, int l) {
    rebind(F);
    const int NT = moe_tables(F, l);
    PolMoeDown P; P.tcls = (const LAS int*)(F.lds + MISC_OFF + MO_TCLS); P.ttb = (const LAS int*)(F.lds + MISC_OFF + MO_TTB); P.cnts = (const LAS int*)(F.lds + MISC_OFF + MO_CNT);
    P.NT = NT; P.G = F.G; P.c = F.bid; P.A = (const char*)(F.ws + WS_BIG); P.B = (const char*)(F.ws + WS_WD) + (size_t)l * 16 * 1024 * 1024; P.ri = (const RInfo*)(F.ws + WS_RINFO); P.Y = (bf16*)(F.ws + WS_Y);
    pg8::gemm_phase<PolMoeDown, true>(F.lds, P);
}
__device__ __forceinline__ void phase_inproj(Frame& F, int l) {
    rebind(F);
    PolInProj P; P.so.init(T, DINW, F.G, F.bid); P.A = (const char*)(F.ws + WS_UA); P.B = (const char*)(F.ws + WS_WIN) + (size_t)l * DINW * 2048; P.O = (bf16*)(F.ws + WS_BIG);
    pg8::gemm_phase<PolInProj, true>(F.lds, P);
}
__device__ __forceinline__ void phase_outproj(Frame& F, int l) {
    rebind(F);
    PolOutProj P; P.so.init(T, D, F.G, F.bid); P.A = (const char*)(F.ws + WS_UA); P.B = (const char*)(F.ws + WS_WOUT) + (size_t)l * D * 2048; P.C = (float*)(F.ws + WS_BIG);
    pg8::gemm_phase<PolOutProj, true>(F.lds, P);
}

#include <cstdlib>
#include <vector>

#define XB_TMO      128
#define XB_XCNT(j)  (256  + 64 * (j))
#define XB_XSUB(j)  (1280 + 64 * (j))
#define XB_XGEN(j)  (2304 + 64 * (j))
#define XB_TOP      3328
#define XB_TOPGEN   3392
#define XCD_BAR_WORDS 3456
#define XB_SPIN_CAP (1u << 18)

__device__ __forceinline__ unsigned xb_ld(unsigned* p)              { return __hip_atomic_load(p, __ATOMIC_RELAXED, __HIP_MEMORY_SCOPE_AGENT); }
__device__ __forceinline__ unsigned xb_add(unsigned* p, unsigned v) { return __hip_atomic_fetch_add(p, v, __ATOMIC_RELAXED, __HIP_MEMORY_SCOPE_AGENT); }
__device__ __forceinline__ unsigned xb_xcc_id() { return (unsigned)__builtin_amdgcn_s_getreg((3 << 11) | 20) & 0xFu; }
#define XB_SPIN(cond, bar) do { unsigned _sp = 0; while (cond) { __builtin_amdgcn_s_sleep(1); \
    if ((++_sp & 255u) == 0u) { if (xb_ld(&(bar)[XB_TMO])) break; if (_sp > XB_SPIN_CAP) { atomicAdd(&(bar)[XB_TMO], 1u); break; } } } } while (0)

struct XcdBarrier {
    unsigned* bar; unsigned x;
    volatile LAS unsigned* st;
};

__device__ __forceinline__ XcdBarrier xcd_barrier_post(unsigned* bar, volatile LAS unsigned* st) {
    XcdBarrier b; b.bar = bar; b.x = xb_xcc_id(); b.st = st;
    if (threadIdx.x == 0) (void)xb_add(&bar[XB_XCNT(b.x)], 1u);
    return b;
}
__device__ __forceinline__ void xcd_barrier_complete(unsigned* bar, unsigned x, unsigned& nloc, unsigned& nx) {
    const unsigned G = gridDim.x * gridDim.y * gridDim.z;
    unsigned sum, cnt, mine, sp = 0u;
    for (;;) {
        sum = 0u; cnt = 0u; mine = 0u;
#pragma unroll
        for (unsigned j = 0; j < 16; ++j) { const unsigned c = xb_ld(&bar[XB_XCNT(j)]); sum += c; cnt += (c > 0u) ? 1u : 0u; mine = (j == x) ? c : mine; }
        if (sum == G) break;
        __builtin_amdgcn_s_sleep(1);
        if ((++sp & 255u) == 0u) { if (xb_ld(&bar[XB_TMO])) break; if (sp > XB_SPIN_CAP) { atomicAdd(&bar[XB_TMO], 1u); break; } }
    }
    nloc = mine > 0u ? mine : 1u; nx = cnt > 0u ? cnt : 1u;
}

__device__ __forceinline__ void xcd_barrier(const XcdBarrier& b) {
    asm volatile("s_waitcnt vmcnt(0)" ::: "memory");
    __syncthreads();
    if (threadIdx.x == 0) {
        unsigned* bar = b.bar;
        __builtin_amdgcn_s_waitcnt(0);
        unsigned nloc = b.st[0], nx = b.st[1];
        if (nloc == 0u) { xcd_barrier_complete(bar, b.x, nloc, nx); b.st[0] = nloc; b.st[1] = nx; }
        const unsigned old = xb_add(&bar[XB_XSUB(b.x)], 1u);
        const unsigned gen = old / nloc;
        if (old + 1u == (gen + 1u) * nloc) {
            __builtin_amdgcn_fence(__ATOMIC_RELEASE, "agent");
            asm volatile("s_waitcnt vmcnt(0)" ::: "memory");
            const unsigned og = xb_add(&bar[XB_TOP], 1u);
            const unsigned tg = og / nx;
            if (og + 1u == (tg + 1u) * nx) xb_add(&bar[XB_TOPGEN], 1u);
            else XB_SPIN(xb_ld(&bar[XB_TOPGEN]) == tg, bar);
            __builtin_amdgcn_fence(__ATOMIC_ACQUIRE, "agent");
            xb_add(&bar[XB_XGEN(b.x)], 1u);
            asm volatile("s_waitcnt vmcnt(0)" ::: "memory");
        } else {
            XB_SPIN(xb_ld(&bar[XB_XGEN(b.x)]) == gen, bar);
            __builtin_amdgcn_fence(__ATOMIC_ACQUIRE, "agent");
            asm volatile("s_waitcnt vmcnt(0)" ::: "memory");
        }
    }
    __syncthreads();
}

enum { PH_PRO = 0, PH_ROWA, PH_INPROJ, PH_MIXER, PH_OUTPROJ, PH_ROWB, PH_MOEGU, PH_MOEDOWN, PH_ROWC };
#ifndef MK_N_LAUNCHES
#define MK_N_LAUNCHES 1
#endif
__device__ __forceinline__ void frame_init(Frame& F, const Args& args, unsigned char* lds) {
    F.lds = (LAS unsigned char*)lds; F.ws = F.ws0 = args.ws; F.ctl = (gu32*)(args.ws + WS_CTL); F.out = F.out0 = args.out;
    F.ap = (KArgs)__builtin_amdgcn_kernarg_segment_ptr();
    F.tid = threadIdx.x; F.lane = F.tid & 63; F.wave = __builtin_amdgcn_readfirstlane(F.tid >> 6); F.G = gridDim.x;
}
#if MK_N_LAUNCHES == 1
__global__ void __launch_bounds__(NTHR, 2) fwd(Args args) {
    extern __shared__ __attribute__((aligned(16))) unsigned char lds[];
    Frame F; frame_init(F, args, lds);
    for (int u = F.tid; u < (LDS_BYTES - MISC_OFF) / 4; u += NTHR) ((LAS unsigned*)(F.lds + MISC_OFF))[u] = 0u;
    __syncthreads();
    const XcdBarrier bar = xcd_barrier_post((unsigned*)(args.ws + WS_CTL) + CW_BAR, (volatile LAS unsigned*)(F.lds + MISC_OFF + MO_BAR));
#define GRID_BAR() do { XcdBarrier bb_ = bar; size_t zo_ = 0; asm volatile("" : "+s"(zo_), "+s"(bb_.x)); bb_.bar = bar.bar + zo_; xcd_barrier(bb_); } while (0)
    phase_prologue(F); GRID_BAR();
    phase_rowA(F); GRID_BAR();
    static_assert(NL == 2, "two layers written out (no runtime layer loop: nothing to hoist out of it)");
#define LAYER(l, LASTL) do { phase_inproj(F, l); GRID_BAR(); phase_mixer(F, l); GRID_BAR(); phase_outproj(F, l); GRID_BAR(); phase_rowB(F, l); GRID_BAR(); \
        phase_moe_gu(F, l); GRID_BAR(); phase_moe_down(F, l); GRID_BAR(); phase_rowC(F, l); if (!(LASTL)) GRID_BAR(); } while (0)
    LAYER(0, false);
    LAYER(1, true);
#undef LAYER
}
#else
template <int PH>
__global__ void __launch_bounds__(NTHR, 2) k_phase(Args args) {
    extern __shared__ __attribute__((aligned(16))) unsigned char lds[];
    Frame F; frame_init(F, args, lds);
    const int l = args.l;
    if constexpr (PH == PH_PRO) phase_prologue(F);
    if constexpr (PH == PH_ROWA) phase_rowA(F);
    if constexpr (PH == PH_INPROJ) phase_inproj(F, l);
    if constexpr (PH == PH_MIXER) phase_mixer(F, l);
    if constexpr (PH == PH_OUTPROJ) phase_outproj(F, l);
    if constexpr (PH == PH_ROWB) phase_rowB(F, l);
    if constexpr (PH == PH_MOEGU) phase_moe_gu(F, l);
    if constexpr (PH == PH_MOEDOWN) phase_moe_down(F, l);
    if constexpr (PH == PH_ROWC) phase_rowC(F, l);
}
template <int PH> static bool launch_phase(const Args& a, int grid, hipStream_t stream) {
    static bool attr = false;
    if (!attr) { if (hipFuncSetAttribute((const void*)k_phase<PH>, hipFuncAttributeMaxDynamicSharedMemorySize, LDS_BYTES) != hipSuccess) { fprintf(stderr, "kernel_launch: hipFuncSetAttribute failed (phase %d)\n", PH); return false; } attr = true; }
    hipLaunchKernelGGL(k_phase<PH>, dim3(grid), dim3(NTHR), LDS_BYTES, stream, a);
    const hipError_t le = hipPeekAtLastError();
    if (le != hipSuccess) { fprintf(stderr, "kernel_launch: launch of phase %d failed: %s\n", PH, hipGetErrorName(le)); return false; }
    return true;
}
#endif

extern "C" void kernel_launch(void* const* d_in, const int* in_sizes, int n_in, void* d_out, int out_size, void* d_ws, size_t ws_size, hipStream_t stream) {
    static int grid = 0;
    if (grid == 0) {
        if (n_in != 20 || in_sizes[0] != T * D || out_size != T * D || ws_size < WS_END) { fprintf(stderr, "kernel_launch: unexpected shapes (n_in %d, in0 %d, out %d, ws %zu < %zu)\n", n_in, n_in > 0 ? in_sizes[0] : -1, out_size, ws_size, (size_t)WS_END); grid = -1; return; }
        int dev = 0, cus = 0;
        if (hipGetDevice(&dev) != hipSuccess || hipDeviceGetAttribute(&cus, hipDeviceAttributeMultiprocessorCount, dev) != hipSuccess) { grid = -1; return; }
#if MK_N_LAUNCHES == 1
        if (hipFuncSetAttribute((const void*)fwd, hipFuncAttributeMaxDynamicSharedMemorySize, LDS_BYTES) != hipSuccess) { fprintf(stderr, "kernel_launch: hipFuncSetAttribute failed\n"); grid = -1; return; }
        int per_cu = 0;
        if (hipOccupancyMaxActiveBlocksPerMultiprocessor(&per_cu, (const void*)fwd, NTHR, LDS_BYTES) != hipSuccess || per_cu < 1) { fprintf(stderr, "kernel_launch: occupancy query reports %d workgroups per CU; nothing launched\n", per_cu); grid = -1; return; }
        (void)hipGetLastError();
#endif
        grid = cus;
    }
    if (grid < 0) return;
    if (hipMemsetAsync((char*)d_ws + WS_CTL, 0, CTL_ZERO_BYTES, stream) != hipSuccess) return;
    Args a{};
    for (int i = 0; i < 20; ++i) a.in[i] = (const float*)d_in[i];
    a.out = (float*)d_out; a.ws = (unsigned char*)d_ws; a.l = 0; a.pad = 0;
#if MK_N_LAUNCHES == 1
    hipLaunchKernelGGL(fwd, dim3(grid), dim3(NTHR), LDS_BYTES, stream, a);
    const hipError_t le = hipPeekAtLastError();
    if (le != hipSuccess) fprintf(stderr, "kernel_launch: launch failed: %s\n", hipGetErrorName(le));
#else
#define LP(PH) do { if (!launch_phase<PH>(a, grid, stream)) return; } while (0)
    LP(PH_PRO);
    LP(PH_ROWA);
    for (int l = 0; l < NL; ++l) {
        a.l = l;
        LP(PH_INPROJ); LP(PH_MIXER); LP(PH_OUTPROJ); LP(PH_ROWB); LP(PH_MOEGU); LP(PH_MOEDOWN); LP(PH_ROWC);
    }
#endif
}
```

```cpp
#include <hip/hip_runtime.h>
#include <cstdio>
#include <cstdint>

#define GAS __attribute__((address_space(1)))
#define LAS __attribute__((address_space(3)))
typedef unsigned short bf16;
typedef short bf16x8 __attribute__((ext_vector_type(8)));
typedef float f32x4 __attribute__((ext_vector_type(4)));
typedef float f32x2 __attribute__((ext_vector_type(2)));
typedef unsigned u32x4 __attribute__((ext_vector_type(4)));
typedef unsigned u32x2 __attribute__((ext_vector_type(2)));
typedef GAS unsigned gu32;
#define RLX_AGENT __ATOMIC_RELAXED, __HIP_MEMORY_SCOPE_AGENT
#define LDS_WAIT() asm volatile("s_waitcnt lgkmcnt(0)" ::: "memory")
#define VM_WAIT() asm volatile("s_waitcnt vmcnt(0)" ::: "memory")

constexpr int T = 32768, D = 1024, SEQ = 2048, NL = 2, DINW = 3584, DIN_SRC = 3592;
constexpr int NCLS = 24, CLS_CAP = 32768, MAXTILES = 160;
constexpr float ALPHA = 1.41421356237309505f, LN_EPS = 1e-5f, QSCALE = 0.08838834764831845f;
constexpr int NWAVES = 8, NTHR = 512;

constexpr size_t MiB = 1u << 20;
constexpr size_t WS_CTL = 0, CTL_ZERO_BYTES = 1 * MiB;
constexpr size_t WS_MOD = 1 * MiB;
constexpr size_t WS_GATES = 2 * MiB;
constexpr size_t WS_RINFO = 4 * MiB;
constexpr size_t WS_WIN = 16 * MiB;
constexpr size_t WS_WOUT = 30 * MiB;
constexpr size_t WS_WGU = 34 * MiB;
constexpr size_t WS_WD = 98 * MiB;
constexpr size_t WS_UA = 130 * MiB;
constexpr size_t WS_BIG = 194 * MiB;
constexpr size_t WS_X1 = WS_BIG + 128 * MiB;
constexpr size_t WS_Y = WS_UA;
constexpr size_t WS_END = 450 * MiB;
static_assert((size_t)(T + NCLS * 256) * 1024 * 2 <= 128 * MiB, "HID fits below X1");
constexpr int CW_TMO = 0, CW_CODE = 1, CW_CNT = 64, CW_BAR = 4096;

constexpr int RING_BYTES = 131072, MISC_OFF = RING_BYTES, LDS_BYTES = 147456;
constexpr int MO_BAR = 0, MO_TCLS = 64, MO_TTB = 1024, MO_CNT = 2048, MO_NT = 2176, MO_LCNT = 2304, MO_LBASE = 2432, MO_REC = 4096, MO_SG = 8192;

struct RInfo { int token; float wa; float wb; int pad; };

__device__ __forceinline__ unsigned f2bf(float f) { unsigned u = __builtin_bit_cast(unsigned, f); return (u + 0x7fffu + ((u >> 16) & 1u)) >> 16; }
__device__ __forceinline__ unsigned pk2(float lo, float hi) { return f2bf(lo) | (f2bf(hi) << 16); }
__device__ __forceinline__ float bf_lo(unsigned w) { return __builtin_bit_cast(float, w << 16); }
__device__ __forceinline__ float bf_hi(unsigned w) { return __builtin_bit_cast(float, w & 0xffff0000u); }
__device__ __forceinline__ float wave_sum(float v) {
#pragma unroll
    for (int o = 1; o < 64; o <<= 1) v += __shfl_xor(v, o);
    return v;
}
__device__ __forceinline__ float sigmoidf_(float x) { return 1.0f / (1.0f + __expf(-x)); }

__device__ __forceinline__ int opaque_tid() {
    int w = __builtin_amdgcn_readfirstlane(threadIdx.x >> 6); asm volatile("" : "+s"(w));
    int l = __builtin_amdgcn_mbcnt_hi(~0u, __builtin_amdgcn_mbcnt_lo(~0u, 0u)); asm volatile("" : "+v"(l));
    return w * 64 + l; }
namespace pg8 {
constexpr int BM = 256, BK = 64, HALF = 128, HTB = HALF * BK * 2, STAGE_BYTES = 8 * HTB, NXCD = 8, WGM = 8;
__host__ __device__ __forceinline__ int lds_byte(int r, int c) { const int st = (r >> 4) * 2 + (c >> 5), rr = r & 15, cc = c & 31, ob = rr * 64 + cc * 2; return st * 1024 + (ob ^ (((ob >> 9) & 1) << 5)); }
__host__ __device__ __forceinline__ void stage_rc(int b, int& R, int& C) { const int st = b / 1024, sb = b % 1024, swz = sb ^ (((sb >> 9) & 1) << 5); R = (st >> 1) * 16 + swz / 64; C = (st & 1) * 32 + (swz % 64) / 2; }
__host__ __device__ __forceinline__ int perm32(int rho) { const int n = rho >> 4, i = rho & 15; return 8 * (i >> 2) + 4 * n + (i & 3); }
__device__ __forceinline__ unsigned cvt_pk_bf16(float lo, float hi) { unsigned r; asm volatile("v_cvt_pk_bf16_f32 %0, %1, %2" : "=v"(r) : "v"(lo), "v"(hi)); return r; }

__device__ __forceinline__ void stage_rows(int (&sR)[2], int (&sC)[2]) { const int tid = opaque_tid();
#pragma unroll
    for (int i = 0; i < 2; ++i) stage_rc(tid * 16 + i * 8192, sR[i], sC[i]); }
struct StaticOrder {
    int nM, nN, nwg, G, c;
    __device__ void init(int M, int N, int G_, int c_) { nM = M / BM; nN = N / BM; nwg = nM * nN; G = G_; c = c_; }
    __device__ bool next(int i, int& pm, int& pn) const {
        const long L = (long)i * G + c; if (L >= nwg) return false;
        int wgid = (int)L; { const int q = nwg / NXCD, r = nwg % NXCD, xcd = wgid % NXCD, off = wgid / NXCD; wgid = (xcd < r ? xcd * (q + 1) : r * (q + 1) + (xcd - r) * q) + off; }
        const int nig = WGM * nN, gid = wgid / nig, fm = gid * WGM, gsz = (nM - fm) < WGM ? (nM - fm) : WGM;
        pm = fm + ((wgid % nig) % gsz); pn = (wgid % nig) / gsz; return true;
    }
};

template <class P, bool ALIGN_EPI>
__device__ __forceinline__ void gemm_phase(LAS unsigned char* lds, const P& S) {
    const int tid = opaque_tid(), wid = __builtin_amdgcn_readfirstlane(tid >> 6), lane = tid & 63, wr = wid >> 2, wc = wid & 3, fr = lane & 15, fq = lane >> 4;
    constexpr int nt = 16;
    unsigned voffB[2];
#pragma unroll
    for (int i = 0; i < 2; ++i) { int R, C; stage_rc(tid * 16 + i * 8192, R, C); const int Rb = P::PERM ? ((R & ~31) + perm32(R & 31)) : R; voffB[i] = (unsigned)(Rb * P::LDB + C) * 2u; }
    constexpr size_t kstep = (size_t)(BK * 2);
    constexpr size_t hstepB = (size_t)HALF * P::LDB * 2;
    const unsigned ldsw = (unsigned)wid * 1024u;
    const int aoff = lds_byte(wr * 64 + fr, fq * 8), boff = lds_byte(wc * 32 + fr, fq * 8);
#define PG8_SA(b, h) (((b) * 2 + (h)) * HTB)
#define PG8_SB(b, h) ((4 + (b) * 2 + (h)) * HTB)
#define PG8_STAGE(bufoff, gbase, voff) do { _Pragma("unroll") for (int _i = 0; _i < 2; ++_i) \
        __builtin_amdgcn_global_load_lds((const unsigned*)((const char*)(gbase) + (voff)[_i]), (LAS unsigned*)(lds + (bufoff) + ldsw + _i * 8192), 16, 0, 0); } while (0)
#define PG8_LDA(dst, b, h) do { _Pragma("unroll") for (int m = 0; m < 4; ++m) _Pragma("unroll") for (int k = 0; k < 2; ++k) dst[m][k] = *(const LAS bf16x8*)(lds + PG8_SA(b, h) + aoff + m * 2048 + k * 1024); } while (0)
#define PG8_LDB(dst, b, h) do { _Pragma("unroll") for (int n = 0; n < 2; ++n) _Pragma("unroll") for (int k = 0; k < 2; ++k) dst[n][k] = *(const LAS bf16x8*)(lds + PG8_SB(b, h) + boff + n * 2048 + k * 1024); } while (0)
#define PG8_MMA(ai, bj, At, Bt) do { __builtin_amdgcn_s_setprio(1); _Pragma("unroll") for (int m = 0; m < 4; ++m) _Pragma("unroll") for (int n = 0; n < 2; ++n) _Pragma("unroll") for (int k = 0; k < 2; ++k) \
        acc[ai][bj][m][n] = __builtin_amdgcn_mfma_f32_16x16x32_bf16(Bt[n][k], At[m][k], acc[ai][bj][m][n], 0, 0, 0); __builtin_amdgcn_s_setprio(0); } while (0)
#define PG8_WAIT_V(n) asm volatile("s_waitcnt vmcnt(" #n ")" ::: "memory")
#define PG8_WAIT_L(n) asm volatile("s_waitcnt lgkmcnt(" #n ")" ::: "memory")
#define PG8_BAR __builtin_amdgcn_s_barrier()
#define PG8_SCHED __builtin_amdgcn_sched_barrier(0)
    typename P::U cur, nxt; int ui = 0;
    if (!S.next(0, cur)) return;
    f32x4 acc[2][2][4][2];
#pragma unroll
    for (int a = 0; a < 2; ++a)
#pragma unroll
        for (int b = 0; b < 2; ++b)
#pragma unroll
            for (int m = 0; m < 4; ++m)
#pragma unroll
                for (int n = 0; n < 2; ++n) acc[a][b][m][n] = (f32x4){0.f, 0.f, 0.f, 0.f};
    bf16x8 At[4][2], B0[2][2], B1[2][2];
    unsigned offC[2][2];
    S.a_off(cur, offC);
    const char* cA = S.a_base(cur); const char* cB = S.b_base(cur, 0);
    PG8_STAGE(PG8_SB(0, 0), cB, voffB); PG8_STAGE(PG8_SB(0, 1), cB + hstepB, voffB); PG8_STAGE(PG8_SA(0, 0), cA, offC[0]); PG8_STAGE(PG8_SA(0, 1), cA, offC[1]);
    if (wr == 1) PG8_BAR;
    PG8_WAIT_V(2); PG8_BAR;
    PG8_STAGE(PG8_SB(1, 0), cB + kstep, voffB); PG8_STAGE(PG8_SA(1, 0), cA + kstep, offC[0]); PG8_STAGE(PG8_SB(1, 1), cB + hstepB + kstep, voffB);
    PG8_WAIT_V(6); PG8_BAR;
    for (;;) {
        const bool has_next = S.next(ui + 1, nxt);
        const char* nA = cA; const char* nB = cB;
        if (has_next) { nA = S.a_base(nxt); nB = S.b_base(nxt, 0); }
        unsigned o2[2][2];
#pragma nounroll
        for (int t = 0; t < nt; t += 2) {
            const bool last = (t == nt - 2);
            const char* a1 = cA + (size_t)(t + 1) * kstep;
            const char* a2 = last ? nA : cA + (size_t)(t + 2) * kstep; const char* b2 = last ? nB : S.b_base(cur, t + 2);
            const char* a3 = a2 + kstep; const char* b3 = b2 + kstep;
            if (P::GATHER && last && has_next) S.a_off(nxt, o2);
            else {
#pragma unroll
                for (int h = 0; h < 2; ++h)
#pragma unroll
                    for (int i = 0; i < 2; ++i) o2[h][i] = offC[h][i]; }
            PG8_LDB(B0, 0, 0); PG8_LDB(B1, 0, 1); PG8_SCHED; PG8_LDA(At, 0, 0); PG8_STAGE(PG8_SA(1, 1), a1, offC[1]);
            PG8_WAIT_V(8); PG8_WAIT_L(0); PG8_BAR; PG8_MMA(0, 0, At, B0); PG8_MMA(0, 1, At, B1); PG8_BAR; PG8_SCHED;
            PG8_LDA(At, 0, 1); PG8_STAGE(PG8_SB(0, 0), b2, voffB); PG8_STAGE(PG8_SB(0, 1), b2 + hstepB, voffB); PG8_STAGE(PG8_SA(0, 0), a2, o2[0]);
            PG8_WAIT_V(8); PG8_WAIT_L(0); PG8_BAR; PG8_MMA(1, 0, At, B0); PG8_MMA(1, 1, At, B1); PG8_BAR; PG8_SCHED;
            PG8_LDB(B0, 1, 0); PG8_LDB(B1, 1, 1); PG8_SCHED; PG8_LDA(At, 1, 0); PG8_STAGE(PG8_SA(0, 1), a2, o2[1]);
            PG8_WAIT_V(8); PG8_WAIT_L(0); PG8_BAR; PG8_MMA(0, 0, At, B0); PG8_MMA(0, 1, At, B1); PG8_BAR; PG8_SCHED;
            PG8_LDA(At, 1, 1); PG8_STAGE(PG8_SB(1, 0), b3, voffB); PG8_STAGE(PG8_SB(1, 1), b3 + hstepB, voffB); PG8_STAGE(PG8_SA(1, 0), a3, o2[0]);
            PG8_WAIT_V(8); PG8_WAIT_L(0); PG8_BAR; PG8_MMA(1, 0, At, B0); PG8_MMA(1, 1, At, B1); PG8_BAR; PG8_SCHED;
        }
        if constexpr (ALIGN_EPI) { if (wr == 0) PG8_BAR; }
        S.epi(acc, cur, wr, wc, fr, fq);
        if (!has_next) break;
#pragma unroll
        for (int a = 0; a < 2; ++a)
#pragma unroll
            for (int b = 0; b < 2; ++b)
#pragma unroll
                for (int m = 0; m < 4; ++m)
#pragma unroll
                    for (int n = 0; n < 2; ++n) acc[a][b][m][n] = (f32x4){0.f, 0.f, 0.f, 0.f};
        cur = nxt; cA = nA; cB = nB; ++ui;
        if constexpr (P::GATHER) {
#pragma unroll
            for (int h = 0; h < 2; ++h)
#pragma unroll
                for (int i = 0; i < 2; ++i) offC[h][i] = o2[h][i]; }
        if constexpr (ALIGN_EPI) { if (wr == 1) PG8_BAR; }
    }
    PG8_WAIT_V(0);
    if constexpr (!ALIGN_EPI) { if (wr == 0) PG8_BAR; }
    PG8_BAR;
#undef PG8_SA
#undef PG8_SB
#undef PG8_STAGE
#undef PG8_LDA
#undef PG8_LDB
#undef PG8_MMA
#undef PG8_WAIT_V
#undef PG8_WAIT_L
#undef PG8_BAR
#undef PG8_SCHED
}
}

struct Args { const float* in[20]; float* out; unsigned char* ws; int l, pad; };
struct ArgsG { const GAS float* in[20]; float* out; unsigned char* ws; int l, pad; };
typedef __attribute__((address_space(4))) const ArgsG* KArgs;
typedef const GAS float* gin;
struct Frame {
    LAS unsigned char* lds;
    gu32* ctl;
    unsigned char* ws; unsigned char* ws0;
    KArgs ap;
    float* out; float* out0;
    int tid, lane, wave, G, bid;
    __device__ __forceinline__ gin in(int i) const { return ap->in[i]; }
};
__device__ __forceinline__ void rebind(Frame& F) {
    F.tid = opaque_tid(); F.lane = F.tid & 63; F.wave = __builtin_amdgcn_readfirstlane(F.tid >> 6);
    KArgs ap = (KArgs)__builtin_amdgcn_kernarg_segment_ptr(); asm volatile("" : "+s"(ap)); F.ap = ap;
    size_t z = 0; asm volatile("" : "+s"(z));
    F.ws = F.ws0 + z; F.ctl = (gu32*)(F.ws + WS_CTL); F.out = F.out0 + z;
    int g = gridDim.x; asm volatile("" : "+s"(g)); F.G = g;
    int b = blockIdx.x; asm volatile("" : "+s"(b)); F.bid = b;
}
enum { I_X = 0, I_C, I_WADA, I_BADA, I_WIN, I_BG, I_MHW, I_WCONV, I_WOUT, I_LN1G, I_LN1B, I_WGRP, I_BGRP, I_WR, I_BR, I_WGATE, I_WUP, I_WDOWN, I_LN2G, I_LN2B };

struct UnitS { int pm, pn; };
struct PolInProj {
    typedef UnitS U; static constexpr bool PERM = true, GATHER = false; static constexpr int LDB = 1024;
    pg8::StaticOrder so; const char* A; const char* B; bf16* O;
    __device__ __forceinline__ bool next(int i, U& u) const { return so.next(i, u.pm, u.pn); }
    __device__ __forceinline__ const char* a_base(const U& u) const { return A + (size_t)u.pm * (256 * 2048); }
    __device__ __forceinline__ void a_off(const U&, unsigned (&o)[2][2]) const { int sR[2], sC[2]; pg8::stage_rows(sR, sC);
#pragma unroll
        for (int h = 0; h < 2; ++h)
#pragma unroll
            for (int i = 0; i < 2; ++i) o[h][i] = (unsigned)((h * 128 + sR[i]) * 1024 + sC[i]) * 2u; }
    __device__ __forceinline__ const char* b_base(const U& u, int kt) const { return B + (size_t)u.pn * (256 * 2048) + (size_t)kt * 128; }
    __device__ __forceinline__ void epi(const f32x4 (&acc)[2][2][4][2], const U& u, int wr, int wc, int fr, int fq) const {
        const int row0 = u.pm * 256 + wr * 64 + fr, col0 = u.pn * 256 + wc * 32 + 8 * fq;
#pragma unroll
        for (int ai = 0; ai < 2; ++ai)
#pragma unroll
            for (int m = 0; m < 4; ++m) { bf16* rowp = O + (size_t)(row0 + ai * 128 + m * 16) * DINW + col0;
#pragma unroll
                for (int bj = 0; bj < 2; ++bj) { const f32x4 v0 = acc[ai][bj][m][0], v1 = acc[ai][bj][m][1];
                    u32x4 w; w.x = pg8::cvt_pk_bf16(v0[0], v0[1]); w.y = pg8::cvt_pk_bf16(v0[2], v0[3]); w.z = pg8::cvt_pk_bf16(v1[0], v1[1]); w.w = pg8::cvt_pk_bf16(v1[2], v1[3]);
                    *(u32x4*)(rowp + bj * 128) = w; } }
    }
};
struct PolOutProj {
    typedef UnitS U; static constexpr bool PERM = false, GATHER = false; static constexpr int LDB = 1024;
    pg8::StaticOrder so; const char* A; const char* B; float* C;
    __device__ __forceinline__ bool next(int i, U& u) const { return so.next(i, u.pm, u.pn); }
    __device__ __forceinline__ const char* a_base(const U& u) const { return A + (size_t)u.pm * (256 * 2048); }
    __device__ __forceinline__ void a_off(const U&, unsigned (&o)[2][2]) const { int sR[2], sC[2]; pg8::stage_rows(sR, sC);
#pragma unroll
        for (int h = 0; h < 2; ++h)
#pragma unroll
            for (int i = 0; i < 2; ++i) o[h][i] = (unsigned)((h * 128 + sR[i]) * 1024 + sC[i]) * 2u; }
    __device__ __forceinline__ const char* b_base(const U& u, int kt) const { return B + (size_t)u.pn * (256 * 2048) + (size_t)kt * 128; }
    __device__ __forceinline__ void epi(const f32x4 (&acc)[2][2][4][2], const U& u, int wr, int wc, int fr, int fq) const {
        const int row0 = u.pm * 256 + wr * 64 + fr, col0 = u.pn * 256 + wc * 32 + 4 * fq;
#pragma unroll
        for (int ai = 0; ai < 2; ++ai)
#pragma unroll
            for (int m = 0; m < 4; ++m) { float* rowp = C + (size_t)(row0 + ai * 128 + m * 16) * D + col0;
#pragma unroll
                for (int bj = 0; bj < 2; ++bj)
#pragma unroll
                    for (int n = 0; n < 2; ++n) *(f32x4*)(rowp + bj * 128 + n * 16) = acc[ai][bj][m][n]; }
    }
};
struct UnitM { int tile, pn, cls, tb, cnt; };
__device__ __forceinline__ int pair_a(int p) { return p < 3 ? 0 : (p < 5 ? 1 : 2); }
__device__ __forceinline__ int pair_b(int p) { return p < 3 ? p + 1 : (p < 5 ? p - 1 : 3); }
struct PolMoeGU {
    typedef UnitM U; static constexpr bool PERM = true, GATHER = true; static constexpr int LDB = 1024;
    const LAS int* tcls; const LAS int* ttb; const LAS int* cnts; int NT, G, c;
    const char* A; const char* B  ; const RInfo* ri; bf16* H;
    __device__ __forceinline__ bool next(int i, U& u) const { const int L = i * G + c; const int tile = L >> 3; if (tile >= NT) return false;
        u.tile = tile; u.pn = L & 7; u.cls = tcls[tile]; u.tb = ttb[tile]; u.cnt = cnts[u.cls]; return true; }
    __device__ __forceinline__ const char* a_base(const U&) const { return A; }
    __device__ __forceinline__ void a_off(const U& u, unsigned (&o)[2][2]) const { int sR[2], sC[2]; pg8::stage_rows(sR, sC);
#pragma unroll
        for (int h = 0; h < 2; ++h)
#pragma unroll
            for (int i = 0; i < 2; ++i) { int rr = u.tb + h * 128 + sR[i]; if (rr >= u.cnt) rr = 0; const int tok = ri[(size_t)u.cls * CLS_CAP + rr].token; o[h][i] = (unsigned)tok * 2048u + (unsigned)sC[i] * 2u; } }
    __device__ __forceinline__ const char* b_base(const U& u, int kt) const { const int g = u.cls / 6, p = u.cls - g * 6, e = (u.pn >> 2) ? pair_b(p) : pair_a(p);
        return B + ((size_t)(g * 4 + e) * 1024 + (size_t)(u.pn & 3) * 256) * 2048 + (size_t)kt * 128; }
    __device__ __forceinline__ void epi(const f32x4 (&acc)[2][2][4][2], const U& u, int wr, int wc, int fr, int fq) const {
        const int slot = u.pn >> 2, ct = u.pn & 3;
#pragma unroll
        for (int ai = 0; ai < 2; ++ai)
#pragma unroll
            for (int m = 0; m < 4; ++m) { const int r = ai * 128 + wr * 64 + m * 16 + fr, rr = u.tb + r; const bool valid = rr < u.cnt;
                float w = 0.f; if (valid) { const RInfo* q = ri + (size_t)u.cls * CLS_CAP + rr; w = slot ? q->wb : q->wa; }
                float hv[8];
#pragma unroll
                for (int n = 0; n < 2; ++n)
#pragma unroll
                    for (int j = 0; j < 4; ++j) { const float g = acc[ai][0][m][n][j], up = acc[ai][1][m][n][j]; hv[n * 4 + j] = g * __builtin_amdgcn_rcpf(1.0f + __expf(-g)) * up * w; }
                u32x4 o; o.x = pg8::cvt_pk_bf16(hv[0], hv[1]); o.y = pg8::cvt_pk_bf16(hv[2], hv[3]); o.z = pg8::cvt_pk_bf16(hv[4], hv[5]); o.w = pg8::cvt_pk_bf16(hv[6], hv[7]);
                if (valid) *(u32x4*)(H + (size_t)(u.tile * 256 + r) * 1024 + slot * 512 + ct * 128 + wc * 32 + 8 * fq) = o; }
    }
};
struct PolMoeDown {
    typedef UnitM U; static constexpr bool PERM = true, GATHER = false; static constexpr int LDB = 512;
    const LAS int* tcls; const LAS int* ttb; const LAS int* cnts; int NT, G, c;
    const char* A  ; const char* B  ; const RInfo* ri; bf16* Y;
    __device__ __forceinline__ bool next(int i, U& u) const { const int L = i * G + c; const int tile = L >> 2; if (tile >= NT) return false;
        u.tile = tile; u.pn = L & 3; u.cls = tcls[tile]; u.tb = ttb[tile]; u.cnt = cnts[u.cls]; return true; }
    __device__ __forceinline__ const char* a_base(const U& u) const { return A + (size_t)u.tile * (256 * 2048); }
    __device__ __forceinline__ void a_off(const U&, unsigned (&o)[2][2]) const { int sR[2], sC[2]; pg8::stage_rows(sR, sC);
#pragma unroll
        for (int h = 0; h < 2; ++h)
#pragma unroll
            for (int i = 0; i < 2; ++i) o[h][i] = (unsigned)((h * 128 + sR[i]) * 1024 + sC[i]) * 2u; }
    __device__ __forceinline__ const char* b_base(const U& u, int kt) const { const int g = u.cls / 6, p = u.cls - g * 6, e = (kt >> 3) ? pair_b(p) : pair_a(p);
        return B + ((size_t)(g * 4 + e) * 1024 + (size_t)u.pn * 256) * 1024 + (size_t)(kt & 7) * 128; }
    __device__ __forceinline__ void epi(const f32x4 (&acc)[2][2][4][2], const U& u, int wr, int wc, int fr, int fq) const {
#pragma unroll
        for (int ai = 0; ai < 2; ++ai)
#pragma unroll
            for (int m = 0; m < 4; ++m) { const int r = ai * 128 + wr * 64 + m * 16 + fr, rr = u.tb + r; const bool valid = rr < u.cnt;
                if (valid) { const int tok = ri[(size_t)u.cls * CLS_CAP + rr].token; bf16* rowp = Y + (size_t)tok * D + u.pn * 256 + wc * 32 + 8 * fq;
#pragma unroll
                    for (int bj = 0; bj < 2; ++bj) { const f32x4 v0 = acc[ai][bj][m][0], v1 = acc[ai][bj][m][1];
                        u32x4 w; w.x = pg8::cvt_pk_bf16(v0[0], v0[1]); w.y = pg8::cvt_pk_bf16(v0[2], v0[3]); w.z = pg8::cvt_pk_bf16(v1[0], v1[1]); w.w = pg8::cvt_pk_bf16(v1[2], v1[3]);
                        *(u32x4*)(rowp + bj * 128) = w; } } }
    }
};

__device__ __forceinline__ void transpose_item(gin W, int ldw, int k0, int n0, bf16* WT, int ldk, int drow0, float scale, LAS float* scr, int lane) {
#pragma unroll 8
    for (int i = 0; i < 32; ++i) { const int kk = 2 * i + (lane >> 5); scr[kk * 33 + (lane & 31)] = W[(size_t)(k0 + kk) * ldw + n0 + (lane & 31)]; }
    LDS_WAIT(); asm volatile("" ::: "memory");
    const int c = lane & 7;
#pragma unroll
    for (int j = 0; j < 4; ++j) { const int n = (lane >> 3) + 8 * j; const LAS float* s = scr + (8 * c) * 33 + n;
        u32x4 o; o.x = pk2(s[0 * 33] * scale, s[1 * 33] * scale); o.y = pk2(s[2 * 33] * scale, s[3 * 33] * scale); o.z = pk2(s[4 * 33] * scale, s[5 * 33] * scale); o.w = pk2(s[6 * 33] * scale, s[7 * 33] * scale);
        *(u32x4*)(WT + (size_t)(drow0 + n) * ldk + k0 + 8 * c) = o; }
    LDS_WAIT(); asm volatile("" ::: "memory");
}
__device__ __forceinline__ void phase_prologue(Frame& F) {
    rebind(F);
    {
        LAS float* scr = (LAS float*)(F.lds + F.wave * 16384);
        const int gw = F.bid * NWAVES + F.wave, NGW = F.G * NWAVES;
        constexpr int I_IN = NL * 16 * 112, I_OUT = NL * 16 * 32, I_G = NL * 16 * 256, I_DN = NL * 16 * 256;
        constexpr int NITEMS = I_IN + I_OUT + 2 * I_G + I_DN;
        for (int it = gw; it < NITEMS; it += NGW) {
            int r = it;
            if (r < I_IN) { const int l = r / 1792, q = r % 1792, kb = q / 112, nb = q % 112, nd = nb * 32, ns = nd < 2048 ? nd : nd + 8;
                transpose_item(F.in(I_WIN) + (size_t)l * D * DIN_SRC, DIN_SRC, kb * 64, ns, (bf16*)(F.ws + WS_WIN) + (size_t)l * DINW * D, D, nd, nd < 512 ? QSCALE : 1.0f, scr, F.lane); continue; }
            r -= I_IN;
            if (r < I_OUT) { const int l = r / 512, q = r % 512, kb = q / 32, nb = q % 32;
                transpose_item(F.in(I_WOUT) + (size_t)l * D * D, D, kb * 64, nb * 32, (bf16*)(F.ws + WS_WOUT) + (size_t)l * D * D, D, nb * 32, 1.0f, scr, F.lane); continue; }
            r -= I_OUT;
            if (r < 2 * I_G) { const int up = r >= I_G; if (up) r -= I_G; const int mat = r / 256, q = r % 256, kb = q / 16, nb = q % 16, f0 = nb * 32;
                transpose_item(F.in(up ? I_WUP : I_WGATE) + (size_t)mat * D * 512, 512, kb * 64, f0, (bf16*)(F.ws + WS_WGU) + (size_t)mat * 1024 * 1024, 1024, (f0 >> 7) * 256 + (f0 & 127) + (up ? 128 : 0), 1.0f, scr, F.lane); continue; }
            r -= 2 * I_G;
            { const int mat = r / 256, q = r % 256, kb = q / 32, nb = q % 32;
                transpose_item(F.in(I_WDOWN) + (size_t)mat * 512 * D, D, kb * 64, nb * 32, (bf16*)(F.ws + WS_WD) + (size_t)mat * 1024 * 512, 512, nb * 32, 1.0f, scr, F.lane); }
        }
    }
    __syncthreads();
    {
        LAS float* cond = (LAS float*)F.lds;
        LAS float* red = (LAS float*)(F.lds + 65536);
        bool have = false;
        for (int un = F.bid; un < NL * 192; un += F.G) {
            if (!have) { for (int i = F.tid; i < 16 * 1024; i += NTHR) { const float c = F.in(I_C)[i]; cond[i] = c * sigmoidf_(c); } have = true; }
            __syncthreads();
            const int l = un / 192, n0 = (un % 192) * 32, n = F.tid & 31, ks = F.tid >> 5;
            gin W = F.in(I_WADA) + (size_t)l * D * 6144 + n0 + n;
            float acc[16];
#pragma unroll
            for (int b = 0; b < 16; ++b) acc[b] = 0.f;
            for (int kk = 0; kk < 64; ++kk) { const int k = ks * 64 + kk; const float w = W[(size_t)k * 6144];
#pragma unroll
                for (int b = 0; b < 16; ++b) acc[b] += cond[b * 1024 + k] * w; }
#pragma unroll
            for (int b = 0; b < 16; ++b) red[(ks * 16 + b) * 32 + n] = acc[b];
            __syncthreads();
            { const int b = F.tid >> 5; float s = 0.f;
#pragma unroll
              for (int k2 = 0; k2 < 16; ++k2) s += red[(k2 * 16 + b) * 32 + n];
              ((float*)(F.ws + WS_MOD))[((size_t)l * 16 + b) * 6144 + n0 + n] = s + F.in(I_BADA)[l * 6144 + n0 + n]; }
        }
    }
}

__device__ __forceinline__ void stage_cols_T(LAS float* dst, gin src, int ld, int col0, int NC, int tid) {
    for (int idx = tid; idx < NC * 1024; idx += NTHR) { const int k = idx / NC, c = idx - k * NC; dst[c * 1024 + k] = src[(size_t)k * ld + col0 + c]; }
}
__device__ __forceinline__ void modulate_gates(Frame& F, const f32x4 (&xo)[4], int m, int lg, const LAS float* wgT) {
    const float* mod = (const float*)(F.ws + WS_MOD) + ((size_t)lg * 16 + (m >> 11)) * 6144;
    f32x4 u[4];
#pragma unroll
    for (int j = 0; j < 4; ++j) { const int col = 256 * j + 4 * F.lane; const f32x4 sh = *(const f32x4*)(mod + col), sc = *(const f32x4*)(mod + 1024 + col); u[j] = xo[j] * (1.0f + sc) + sh; }
    bf16* up = (bf16*)(F.ws + WS_UA) + (size_t)m * D;
#pragma unroll
    for (int j = 0; j < 4; ++j) { u32x2 w; w.x = pk2(u[j][0], u[j][1]); w.y = pk2(u[j][2], u[j][3]); *(u32x2*)(up + 256 * j + 4 * F.lane) = w; }
    float g[8];
#pragma unroll
    for (int c = 0; c < 8; ++c) { float s = 0.f;
#pragma unroll
        for (int j = 0; j < 4; ++j) { const f32x4 w = *(const LAS f32x4*)(wgT + c * 1024 + 256 * j + 4 * F.lane); s += (u[j][0] * w[0] + u[j][1] * w[1]) + (u[j][2] * w[2] + u[j][3] * w[3]); }
        g[c] = wave_sum(s); }
    float val = g[0];
#pragma unroll
    for (int c = 1; c < 8; ++c) val = (F.lane == c) ? g[c] : val;
    if (F.lane < 8) ((float*)(F.ws + WS_GATES))[(size_t)m * 8 + F.lane] = val + F.in(I_BG)[lg * 8 + F.lane];
}
__device__ __forceinline__ void ln_row(f32x4 (&z)[4], gin g, gin b, int lane) {
    float s = 0.f;
#pragma unroll
    for (int j = 0; j < 4; ++j) s += (z[j][0] + z[j][1]) + (z[j][2] + z[j][3]);
    const float mean = wave_sum(s) * (1.0f / D); float q = 0.f;
#pragma unroll
    for (int j = 0; j < 4; ++j) { z[j] = z[j] - mean; q += (z[j][0] * z[j][0] + z[j][1] * z[j][1]) + (z[j][2] * z[j][2] + z[j][3] * z[j][3]); }
    const float rstd = 1.0f / sqrtf(wave_sum(q) * (1.0f / D) + LN_EPS);
#pragma unroll
    for (int j = 0; j < 4; ++j) { const int col = 256 * j + 4 * lane; const f32x4 gg = *(const GAS f32x4*)(g + col), bb = *(const GAS f32x4*)(b + col); z[j] = z[j] * rstd * gg + bb; }
}
__device__ __forceinline__ void phase_rowA(Frame& F) {
    rebind(F);
    LAS float* wgT = (LAS float*)(F.lds + 81920);
    stage_cols_T(wgT, F.in(I_WIN), DIN_SRC, 2048, 8, F.tid);
    __syncthreads();
    const int gw = F.bid * NWAVES + F.wave, NGW = F.G * NWAVES;
    for (int m = gw; m < T; m += NGW) {
        f32x4 x[4];
#pragma unroll
        for (int j = 0; j < 4; ++j) x[j] = *(const GAS f32x4*)(F.in(I_X) + (size_t)m * D + 256 * j + 4 * F.lane);
        modulate_gates(F, x, m, 0, wgT);
    }
}
__device__ __forceinline__ void phase_rowB(Frame& F, int l) {
    rebind(F);
    LAS float* wrT = (LAS float*)F.lds;
    LAS int* lcnt = (LAS int*)(F.lds + MISC_OFF + MO_LCNT);
    LAS int* lbase = (LAS int*)(F.lds + MISC_OFF + MO_LBASE);
    LAS int* rec = (LAS int*)(F.lds + MISC_OFF + MO_REC);
    stage_cols_T(wrT, F.in(I_WGRP) + (size_t)l * D * 4, 4, 0, 4, F.tid);
    stage_cols_T(wrT + 4 * 1024, F.in(I_WR) + (size_t)l * D * 16, 16, 0, 16, F.tid);
    if (F.tid < NCLS) lcnt[F.tid] = 0;
    __syncthreads();
    gin xcur = (l == 0) ? F.in(I_X) : (gin)F.out;
    const float* mix = (const float*)(F.ws + WS_BIG);
    float* x1p = (float*)(F.ws + WS_X1);
    RInfo* ri = (RInfo*)(F.ws + WS_RINFO);
    for (int rb = F.bid; rb < T / 128; rb += F.G) {
        for (int rl = F.wave; rl < 128; rl += NWAVES) {
            const int m = rb * 128 + rl;
            const float* mod = (const float*)(F.ws + WS_MOD) + ((size_t)l * 16 + (m >> 11)) * 6144;
            f32x4 z[4];
#pragma unroll
            for (int j = 0; j < 4; ++j) { const int col = 256 * j + 4 * F.lane; const f32x4 xv = *(const GAS f32x4*)(xcur + (size_t)m * D + col), mv = *(const f32x4*)(mix + (size_t)m * D + col), gt = *(const f32x4*)(mod + 2048 + col);
                z[j] = xv * ALPHA + (1.0f + gt) * mv; }
            ln_row(z, F.in(I_LN1G) + l * D, F.in(I_LN1B) + l * D, F.lane);
            f32x4 u[4];
#pragma unroll
            for (int j = 0; j < 4; ++j) { const int col = 256 * j + 4 * F.lane; *(f32x4*)(x1p + (size_t)m * D + col) = z[j];
                const f32x4 sh = *(const f32x4*)(mod + 3072 + col), sc = *(const f32x4*)(mod + 4096 + col); u[j] = z[j] * (1.0f + sc) + sh; }
            bf16* up = (bf16*)(F.ws + WS_UA) + (size_t)m * D;
#pragma unroll
            for (int j = 0; j < 4; ++j) { u32x2 w; w.x = pk2(u[j][0], u[j][1]); w.y = pk2(u[j][2], u[j][3]); *(u32x2*)(up + 256 * j + 4 * F.lane) = w; }
            float lg[20];
#pragma unroll
            for (int c = 0; c < 20; ++c) { float s = 0.f;
#pragma unroll
                for (int j = 0; j < 4; ++j) { const f32x4 w = *(const LAS f32x4*)(wrT + c * 1024 + 256 * j + 4 * F.lane); s += (u[j][0] * w[0] + u[j][1] * w[1]) + (u[j][2] * w[2] + u[j][3] * w[3]); }
                lg[c] = wave_sum(s); }
            float gl[4];
#pragma unroll
            for (int j = 0; j < 4; ++j) gl[j] = lg[j] + F.in(I_BGRP)[l * 4 + j];
            int gi = 0; float gm = gl[0];
#pragma unroll
            for (int j = 1; j < 4; ++j) if (gl[j] > gm) { gm = gl[j]; gi = j; }
            float den = 0.f;
#pragma unroll
            for (int j = 0; j < 4; ++j) den += __expf(gl[j] - gm);
            const float grp_w = 1.0f / den;
            float el[4];
#pragma unroll
            for (int e = 0; e < 4; ++e) { float v = lg[4 + e];
#pragma unroll
                for (int g2 = 1; g2 < 4; ++g2) v = (gi == g2) ? lg[4 + g2 * 4 + e] : v;
                el[e] = v + F.in(I_BR)[l * 16 + gi * 4 + e]; }
            int i1 = 0; float v1 = el[0];
#pragma unroll
            for (int e = 1; e < 4; ++e) if (el[e] > v1) { v1 = el[e]; i1 = e; }
            int i2 = -1; float v2 = -3.0e38f;
#pragma unroll
            for (int e = 0; e < 4; ++e) if (e != i1 && el[e] > v2) { v2 = el[e]; i2 = e; }
            const float ex = __expf(v2 - v1), w1 = grp_w / (1.0f + ex), w2 = grp_w * ex / (1.0f + ex);
            const int ea = i1 < i2 ? i1 : i2, eb = i1 < i2 ? i2 : i1; const float wa = i1 < i2 ? w1 : w2, wb = i1 < i2 ? w2 : w1;
            const int p = ea == 0 ? eb - 1 : (ea == 1 ? eb + 1 : 5), cls = gi * 6 + p;
            if (F.lane == 0) { const int lr = __hip_atomic_fetch_add(lcnt + cls, 1, __ATOMIC_RELAXED, __HIP_MEMORY_SCOPE_WORKGROUP);
                rec[rl * 4 + 0] = cls; rec[rl * 4 + 1] = lr; rec[rl * 4 + 2] = __builtin_bit_cast(int, wa); rec[rl * 4 + 3] = __builtin_bit_cast(int, wb); }
        }
        __syncthreads();
        if (F.tid < NCLS) { const int n = lcnt[F.tid]; lbase[F.tid] = n ? (int)__hip_atomic_fetch_add(F.ctl + CW_CNT + l * 32 + F.tid, (unsigned)n, RLX_AGENT) : 0; }
        __syncthreads();
        if (F.tid < 128) { const int cls = rec[F.tid * 4], pos = lbase[cls] + rec[F.tid * 4 + 1];
            RInfo r; r.token = rb * 128 + F.tid; r.wa = __builtin_bit_cast(float, rec[F.tid * 4 + 2]); r.wb = __builtin_bit_cast(float, rec[F.tid * 4 + 3]); r.pad = 0;
            ri[(size_t)cls * CLS_CAP + pos] = r; }
        __syncthreads();
        if (F.tid < NCLS) lcnt[F.tid] = 0;
        __syncthreads();
    }
}
__device__ __forceinline__ void phase_rowC(Frame& F, int l) {
    rebind(F);
    LAS float* wgT = (LAS float*)(F.lds + 81920);
    if (l + 1 < NL) stage_cols_T(wgT, F.in(I_WIN) + (size_t)(l + 1) * D * DIN_SRC, DIN_SRC, 2048, 8, F.tid);
    __syncthreads();
    const float* x1p = (const float*)(F.ws + WS_X1); const bf16* yp = (const bf16*)(F.ws + WS_Y);
    const int gw = F.bid * NWAVES + F.wave, NGW = F.G * NWAVES;
    for (int m = gw; m < T; m += NGW) {
        const float* mod = (const float*)(F.ws + WS_MOD) + ((size_t)l * 16 + (m >> 11)) * 6144;
        f32x4 z[4];
#pragma unroll
        for (int j = 0; j < 4; ++j) { const int col = 256 * j + 4 * F.lane; const f32x4 xv = *(const f32x4*)(x1p + (size_t)m * D + col), gt = *(const f32x4*)(mod + 5120 + col); const u32x2 yw = *(const u32x2*)(yp + (size_t)m * D + col);
            const f32x4 yv = (f32x4){bf_lo(yw.x), bf_hi(yw.x), bf_lo(yw.y), bf_hi(yw.y)};
            z[j] = xv * ALPHA + (1.0f + gt) * yv; }
        ln_row(z, F.in(I_LN2G) + l * D, F.in(I_LN2B) + l * D, F.lane);
#pragma unroll
        for (int j = 0; j < 4; ++j) *(f32x4*)(F.out + (size_t)m * D + 256 * j + 4 * F.lane) = z[j];
        if (l + 1 < NL) modulate_gates(F, z, m, l + 1, wgT);
    }
}

__device__ __forceinline__ void mlstm_naive_unit(Frame& F, int l, int bh) {
    const int b = bh >> 2, h = bh & 3, tid = F.tid, v = tid >> 2, kp = tid & 3;
    LAS float* Qs = (LAS float*)F.lds; LAS float* Ks = Qs + 64 * 128; LAS float* Vs = Ks + 64 * 128; LAS float* Hb = Vs + 64 * 128;
    LAS float* sg = (LAS float*)(F.lds + MISC_OFF + MO_SG);
    const bf16* proj = (const bf16*)(F.ws + WS_BIG); const float* gates = (const float*)(F.ws + WS_GATES);
    bf16* outp = (bf16*)(F.ws + WS_UA);
    float C[32], nn[32];
#pragma unroll
    for (int j = 0; j < 32; ++j) { C[j] = 0.f; nn[j] = 0.f; }
    float mst = 0.f;
    for (int blk = 0; blk < SEQ / 64; ++blk) {
        const int tok0 = b * SEQ + blk * 64;
#pragma unroll
        for (int i = 0; i < 2; ++i) { const int idx = tid + i * NTHR, row = idx >> 4, c8 = idx & 15; const bf16* p = proj + (size_t)(tok0 + row) * DINW + h * 128 + c8 * 8;
            const u32x4 q = *(const u32x4*)p, k = *(const u32x4*)(p + 512), vv = *(const u32x4*)(p + 1024);
            LAS float* dq = Qs + row * 128 + c8 * 8; LAS float* dk = Ks + row * 128 + c8 * 8; LAS float* dv = Vs + row * 128 + c8 * 8;
#pragma unroll
            for (int e = 0; e < 4; ++e) { dq[2 * e] = bf_lo(q[e]); dq[2 * e + 1] = bf_hi(q[e]); dk[2 * e] = bf_lo(k[e]); dk[2 * e + 1] = bf_hi(k[e]); dv[2 * e] = bf_lo(vv[e]); dv[2 * e + 1] = bf_hi(vv[e]); } }
        if (tid < 64) { const float ip = gates[(size_t)(tok0 + tid) * 8 + h], fp = gates[(size_t)(tok0 + tid) * 8 + 4 + h];
            const float lf = fminf(fp, 0.f) - log1pf(__expf(-fabsf(fp)));
            sg[tid * 2] = lf; sg[tid * 2 + 1] = ip; }
        __syncthreads();
        for (int t = 0; t < 64; ++t) {
            const float lf = sg[t * 2], ig = sg[t * 2 + 1];
            const float mnew = fmaxf(lf + mst, ig), fd = __expf(lf + mst - mnew), ii = __expf(ig - mnew); mst = mnew;
            const float vv = Vs[t * 128 + v] * ii;
            float hp = 0.f, dp = 0.f;
#pragma unroll
            for (int j4 = 0; j4 < 8; ++j4) { const f32x4 kk = *(const LAS f32x4*)(Ks + t * 128 + kp * 32 + j4 * 4), qq = *(const LAS f32x4*)(Qs + t * 128 + kp * 32 + j4 * 4);
#pragma unroll
                for (int e = 0; e < 4; ++e) { const int j = j4 * 4 + e; C[j] = fd * C[j] + vv * kk[e]; nn[j] = fd * nn[j] + ii * kk[e]; hp += C[j] * qq[e]; dp += nn[j] * qq[e]; } }
            hp += __shfl_xor(hp, 1); hp += __shfl_xor(hp, 2); dp += __shfl_xor(dp, 1); dp += __shfl_xor(dp, 2);
            const float hv = hp / fmaxf(fabsf(dp), __expf(-mst));
            if (kp == 0) Hb[t * 128 + v] = hv;
        }
        __syncthreads();
        { const int t = tid >> 3, part = tid & 7; float x[16]; float s = 0.f;
#pragma unroll
          for (int j = 0; j < 16; ++j) { x[j] = Hb[t * 128 + part * 16 + j]; s += x[j]; }
          s += __shfl_xor(s, 1); s += __shfl_xor(s, 2); s += __shfl_xor(s, 4);
          const float mean = s * (1.0f / 128.0f); float q = 0.f;
#pragma unroll
          for (int j = 0; j < 16; ++j) { x[j] -= mean; q += x[j] * x[j]; }
          q += __shfl_xor(q, 1); q += __shfl_xor(q, 2); q += __shfl_xor(q, 4);
          const float rstd = 1.0f / sqrtf(q * (1.0f / 128.0f) + LN_EPS);
          const bf16* op = proj + (size_t)(tok0 + t) * DINW + 1536 + h * 128 + part * 16; gin wn = F.in(I_MHW) + l * 512 + h * 128 + part * 16;
          const u32x4 o0 = *(const u32x4*)op, o1 = *(const u32x4*)(op + 8);
          float r[16];
#pragma unroll
          for (int e = 0; e < 4; ++e) { r[2 * e] = bf_lo(o0[e]); r[2 * e + 1] = bf_hi(o0[e]); r[8 + 2 * e] = bf_lo(o1[e]); r[8 + 2 * e + 1] = bf_hi(o1[e]); }
#pragma unroll
          for (int j = 0; j < 16; ++j) r[j] = x[j] * rstd * wn[j] * sigmoidf_(r[j]);
          u32x4 w0, w1;
#pragma unroll
          for (int e = 0; e < 4; ++e) { w0[e] = pk2(r[2 * e], r[2 * e + 1]); w1[e] = pk2(r[8 + 2 * e], r[8 + 2 * e + 1]); }
          bf16* dp2 = outp + (size_t)(tok0 + t) * D + h * 128 + part * 16; *(u32x4*)dp2 = w0; *(u32x4*)(dp2 + 8) = w1; }
        __syncthreads();
    }
}

#define LBAR() do { asm volatile("s_waitcnt lgkmcnt(0)" ::: "memory"); __builtin_amdgcn_s_barrier(); asm volatile("" ::: "memory"); } while (0)
__device__ __forceinline__ void mlstm_chunk_unit(Frame& F, int l, int bh) {
    const int b = bh >> 2, h = bh & 3, tid = F.tid, lane = F.lane, w = F.wave, fr = lane & 15, fq = lane >> 4;
    LAS unsigned char* L = F.lds;
    constexpr int QS = 0, KS = 17408, KT = 34816, VT = 53248, PS = 71680, CB = 80896, SC = 115712, NV = 119808, HS = 0;
    constexpr int QST = 272, TST = 144, HST = 132;
    const bf16* proj = (const bf16*)(F.ws + WS_BIG); const float* gates = (const float*)(F.ws + WS_GATES); bf16* outp = (bf16*)(F.ws + WS_UA);
    const int tokb = b * SEQ;
    for (int i = lane; i < 16 * QST / 16; i += 64) *(LAS u32x4*)(L + CB + w * 16 * QST + i * 16) = (u32x4){0u, 0u, 0u, 0u};
    if (tid < 128) ((LAS float*)(L + NV))[tid] = 0.f;
    f32x4 acc2[8];
#pragma unroll
    for (int kt = 0; kt < 8; ++kt) acc2[kt] = (f32x4){0.f, 0.f, 0.f, 0.f};
    float m_st = 0.f, g_ip = 0.f, g_fp = 0.f;
    if (w == 0) { g_ip = gates[(size_t)(tokb + lane) * 8 + h]; g_fp = gates[(size_t)(tokb + lane) * 8 + 4 + h]; }
#define MLSTM_SCALARS(sbn) do { \
        const float lf_ = fminf(g_fp, 0.f) - log1pf(__expf(-fabsf(g_fp))); float bc_ = lf_; \
        _Pragma("unroll") for (int d_ = 1; d_ < 64; d_ <<= 1) { const float v_ = __shfl_up(bc_, d_); if (lane >= d_) bc_ += v_; } \
        const float r_ = g_ip - bc_; float pm_ = r_; \
        _Pragma("unroll") for (int d_ = 1; d_ < 64; d_ <<= 1) { const float v_ = __shfl_up(pm_, d_); if (lane >= d_) pm_ = fmaxf(pm_, v_); } \
        const float gtot_ = __shfl(bc_, 63), pm63_ = __shfl(pm_, 63); \
        const float M_ = fmaxf(m_st, pm_), Mx_ = fmaxf(m_st, pm63_); \
        (sbn)[lane] = r_; (sbn)[64 + lane] = M_; (sbn)[128 + lane] = __expf(m_st - M_); (sbn)[192 + lane] = __expf(-(bc_ + M_)); (sbn)[256 + lane] = __expf(r_ - Mx_); \
        if (lane == 0) (sbn)[320] = __expf(m_st - Mx_); \
        m_st = gtot_ + Mx_; } while (0)
    if (w == 0) MLSTM_SCALARS((LAS float*)(L + SC));
    u32x4 rq[2], rk[2], rv[2], ro[2], ro2[2];
#pragma unroll
    for (int i = 0; i < 2; ++i) { const bf16* p = proj + (size_t)(tokb + lane) * DINW + h * 128 + (w + 8 * i) * 8; rq[i] = *(const u32x4*)p; rk[i] = *(const u32x4*)(p + 512); rv[i] = *(const u32x4*)(p + 1024); }
    { const bf16* p = proj + (size_t)(tokb + (tid >> 3)) * DINW + 1536 + h * 128 + (tid & 7) * 16; ro[0] = *(const u32x4*)p; ro[1] = *(const u32x4*)(p + 8); }
    ro2[0] = ro[0]; ro2[1] = ro[1];
    __syncthreads();
    for (int c = 0; c < SEQ / 64; ++c) {
        const LAS float* sb = (const LAS float*)(L + SC + (c & 1) * 2048);
        LAS float* sbn = (LAS float*)(L + SC + ((c + 1) & 1) * 2048);
        const int tok0 = tokb + c * 64;
        const bool more = (c + 1) < SEQ / 64;
        { const float wu = sb[256 + lane];
#pragma unroll
          for (int i = 0; i < 2; ++i) { const int c8 = w + 8 * i;
            *(LAS u32x4*)(L + QS + lane * QST + c8 * 16) = rq[i]; *(LAS u32x4*)(L + KS + lane * QST + c8 * 16) = rk[i];
#pragma unroll
            for (int e = 0; e < 4; ++e) { const int k0 = c8 * 8 + 2 * e;
                *(LAS unsigned short*)(L + KT + k0 * TST + lane * 2) = (unsigned short)f2bf(bf_lo(rk[i][e]) * wu); *(LAS unsigned short*)(L + KT + (k0 + 1) * TST + lane * 2) = (unsigned short)f2bf(bf_hi(rk[i][e]) * wu);
                *(LAS unsigned short*)(L + VT + k0 * TST + lane * 2) = (unsigned short)(rv[i][e] & 0xffffu); *(LAS unsigned short*)(L + VT + (k0 + 1) * TST + lane * 2) = (unsigned short)(rv[i][e] >> 16); } } }
        if (w == 0 && more) { g_ip = gates[(size_t)(tok0 + 64 + lane) * 8 + h]; g_fp = gates[(size_t)(tok0 + 64 + lane) * 8 + 4 + h]; }
        LBAR();
        if (more) {
#pragma unroll
            for (int i = 0; i < 2; ++i) { const bf16* p = proj + (size_t)(tok0 + 64 + lane) * DINW + h * 128 + (w + 8 * i) * 8; rq[i] = *(const u32x4*)p; rk[i] = *(const u32x4*)(p + 512); rv[i] = *(const u32x4*)(p + 1024); }
            const bf16* p = proj + (size_t)(tok0 + 64 + (tid >> 3)) * DINW + 1536 + h * 128 + (tid & 7) * 16; ro2[0] = *(const u32x4*)p; ro2[1] = *(const u32x4*)(p + 8); }
        { const int tt = w >> 1;
#pragma unroll
          for (int j = 0; j < 2; ++j) { const int ts = 2 * (w & 1) + j; f32x4 sa = (f32x4){0.f, 0.f, 0.f, 0.f};
            if (ts <= tt) {
#pragma unroll
                for (int ks = 0; ks < 4; ++ks) { const bf16x8 a = *(const LAS bf16x8*)(L + QS + (tt * 16 + fr) * QST + ks * 64 + fq * 16), bb = *(const LAS bf16x8*)(L + KS + (ts * 16 + fr) * QST + ks * 64 + fq * 16);
                    sa = __builtin_amdgcn_mfma_f32_16x16x32_bf16(a, bb, sa, 0, 0, 0); } }
            const int si = ts * 16 + fr; const float rs = sb[si];
#pragma unroll
            for (int rg = 0; rg < 4; ++rg) { const int ti = tt * 16 + 4 * fq + rg; const float pw = sa[rg] * __expf(rs - sb[64 + ti]);
                *(LAS unsigned short*)(L + PS + ti * TST + si * 2) = (unsigned short)f2bf(si <= ti ? pw : 0.f); } } }
        LBAR();
        { const int t = tid >> 3, part = tid & 7; const u32x4 pp = *(const LAS u32x4*)(L + PS + t * TST + part * 16); float d1 = 0.f, d2 = 0.f;
#pragma unroll
          for (int e = 0; e < 4; ++e) d1 += bf_lo(pp[e]) + bf_hi(pp[e]);
#pragma unroll
          for (int i = 0; i < 2; ++i) { const u32x4 qq = *(const LAS u32x4*)(L + QS + t * QST + part * 32 + i * 16);
#pragma unroll
            for (int e = 0; e < 4; ++e) { const f32x2 nv = *(const LAS f32x2*)(L + NV + (part * 16 + i * 8 + 2 * e) * 4); d2 += bf_lo(qq[e]) * nv[0] + bf_hi(qq[e]) * nv[1]; } }
          d1 += __shfl_xor(d1, 1); d1 += __shfl_xor(d1, 2); d1 += __shfl_xor(d1, 4); d2 += __shfl_xor(d2, 1); d2 += __shfl_xor(d2, 2); d2 += __shfl_xor(d2, 4);
          const float den = d1 + sb[128 + t] * d2;
          if (part == 0) ((LAS float*)(L + SC + (c & 1) * 2048))[384 + t] = 1.0f / fmaxf(fabsf(den), sb[192 + t]); }
        f32x4 n1[4], nI[4]; bf16x8 vf[2];
#pragma unroll
        for (int ks = 0; ks < 2; ++ks) vf[ks] = *(const LAS bf16x8*)(L + VT + (w * 16 + fr) * TST + ks * 64 + fq * 16);
#pragma unroll
        for (int t4 = 0; t4 < 4; ++t4) { n1[t4] = (f32x4){0.f, 0.f, 0.f, 0.f}; nI[t4] = (f32x4){0.f, 0.f, 0.f, 0.f};
#pragma unroll
            for (int ks = 0; ks < 2; ++ks) if (ks * 32 <= t4 * 16 + 15) { const bf16x8 a = *(const LAS bf16x8*)(L + PS + (t4 * 16 + fr) * TST + ks * 64 + fq * 16); n1[t4] = __builtin_amdgcn_mfma_f32_16x16x32_bf16(a, vf[ks], n1[t4], 0, 0, 0); } }
        { bf16x8 cf[4];
#pragma unroll
          for (int ks = 0; ks < 4; ++ks) cf[ks] = *(const LAS bf16x8*)(L + CB + (w * 16 + fr) * QST + ks * 64 + fq * 16);
#pragma unroll
          for (int t4 = 0; t4 < 4; ++t4)
#pragma unroll
            for (int ks = 0; ks < 4; ++ks) { const bf16x8 a = *(const LAS bf16x8*)(L + QS + (t4 * 16 + fr) * QST + ks * 64 + fq * 16); nI[t4] = __builtin_amdgcn_mfma_f32_16x16x32_bf16(a, cf[ks], nI[t4], 0, 0, 0); } }
        LBAR();
#pragma unroll
        for (int t4 = 0; t4 < 4; ++t4)
#pragma unroll
            for (int rg = 0; rg < 4; ++rg) { const int ti = t4 * 16 + 4 * fq + rg; ((LAS float*)(L + HS))[ti * HST + w * 16 + fr] = n1[t4][rg] + sb[128 + ti] * nI[t4][rg]; }
        { const float dec = sb[320];
#pragma unroll
          for (int kt = 0; kt < 8; ++kt) { acc2[kt] = acc2[kt] * dec;
#pragma unroll
            for (int ks = 0; ks < 2; ++ks) { const bf16x8 a = *(const LAS bf16x8*)(L + KT + (kt * 16 + fr) * TST + ks * 64 + fq * 16); acc2[kt] = __builtin_amdgcn_mfma_f32_16x16x32_bf16(a, vf[ks], acc2[kt], 0, 0, 0); }
            u32x2 wv; wv.x = pk2(acc2[kt][0], acc2[kt][1]); wv.y = pk2(acc2[kt][2], acc2[kt][3]);
            *(LAS u32x2*)(L + CB + (w * 16 + fr) * QST + (kt * 16 + 4 * fq) * 2) = wv; }
          if (tid < 128) { float sn = 0.f;
#pragma unroll
            for (int i = 0; i < 8; ++i) { const u32x4 kk = *(const LAS u32x4*)(L + KT + tid * TST + i * 16);
#pragma unroll
                for (int e = 0; e < 4; ++e) sn += bf_lo(kk[e]) + bf_hi(kk[e]); }
            LAS float* np = (LAS float*)(L + NV) + tid; *np = dec * (*np) + sn; } }
        if (w == 0 && more) MLSTM_SCALARS(sbn);
        LBAR();
        { const int t = tid >> 3, part = tid & 7; const float dinv = sb[384 + t]; float x[16]; float sm = 0.f;
#pragma unroll
          for (int i = 0; i < 4; ++i) { const f32x4 hv = *(const LAS f32x4*)(L + HS + (t * HST + part * 16 + i * 4) * 4);
#pragma unroll
            for (int e = 0; e < 4; ++e) { x[i * 4 + e] = hv[e] * dinv; sm += x[i * 4 + e]; } }
          sm += __shfl_xor(sm, 1); sm += __shfl_xor(sm, 2); sm += __shfl_xor(sm, 4);
          const float mean = sm * (1.0f / 128.0f); float qv = 0.f;
#pragma unroll
          for (int j = 0; j < 16; ++j) { x[j] -= mean; qv += x[j] * x[j]; }
          qv += __shfl_xor(qv, 1); qv += __shfl_xor(qv, 2); qv += __shfl_xor(qv, 4);
          const float rstd = 1.0f / sqrtf(qv * (1.0f / 128.0f) + LN_EPS);
          gin wn = F.in(I_MHW) + l * 512 + h * 128 + part * 16;
          float rr[16];
#pragma unroll
          for (int e = 0; e < 4; ++e) { rr[2 * e] = bf_lo(ro[0][e]); rr[2 * e + 1] = bf_hi(ro[0][e]); rr[8 + 2 * e] = bf_lo(ro[1][e]); rr[8 + 2 * e + 1] = bf_hi(ro[1][e]); }
#pragma unroll
          for (int j = 0; j < 16; ++j) rr[j] = x[j] * rstd * wn[j] * sigmoidf_(rr[j]);
          u32x4 w0, w1;
#pragma unroll
          for (int e = 0; e < 4; ++e) { w0[e] = pk2(rr[2 * e], rr[2 * e + 1]); w1[e] = pk2(rr[8 + 2 * e], rr[8 + 2 * e + 1]); }
          bf16* dp2 = outp + (size_t)(tok0 + t) * D + h * 128 + part * 16; *(u32x4*)dp2 = w0; *(u32x4*)(dp2 + 8) = w1; }
        ro[0] = ro2[0]; ro[1] = ro2[1];
        LBAR();
    }
#undef MLSTM_SCALARS
}
__device__ __forceinline__ void conv_items(Frame& F, int l, int first_block, int nblocks) {
    const bf16* proj = (const bf16*)(F.ws + WS_BIG); bf16* outp = (bf16*)(F.ws + WS_UA);
    const int nthreads = nblocks * NTHR;
    for (int id = (F.bid - first_block) * NTHR + F.tid; id < (T / 32) * 64; id += nthreads) {
        const int cg = id & 63, run = id >> 6, t0 = run * 32, c0 = cg * 8;
        float w[3][8];
#pragma unroll
        for (int j = 0; j < 3; ++j)
#pragma unroll
            for (int e = 0; e < 8; ++e) w[j][e] = F.in(I_WCONV)[(size_t)l * 3 * 512 + j * 512 + c0 + e];
        float z1[8], z2[8];
#pragma unroll
        for (int e = 0; e < 8; ++e) { z1[e] = 0.f; z2[e] = 0.f; }
        if ((t0 & (SEQ - 1)) != 0) {
#pragma unroll
            for (int back = 1; back <= 2; ++back) { const bf16* p = proj + (size_t)(t0 - back) * DINW + 2560 + c0; const u32x4 cc = *(const u32x4*)p, ch = *(const u32x4*)(p + 512);
#pragma unroll
                for (int e = 0; e < 4; ++e) { const float a = bf_lo(cc[e]) * bf_lo(ch[e]), b2 = bf_hi(cc[e]) * bf_hi(ch[e]); if (back == 1) { z1[2 * e] = a; z1[2 * e + 1] = b2; } else { z2[2 * e] = a; z2[2 * e + 1] = b2; } } }
        }
        for (int t = t0; t < t0 + 32; ++t) { const bf16* p = proj + (size_t)t * DINW + 2048 + c0; const u32x4 cb = *(const u32x4*)p, cc = *(const u32x4*)(p + 512), ch = *(const u32x4*)(p + 1024);
            float z0[8], y[8];
#pragma unroll
            for (int e = 0; e < 4; ++e) { z0[2 * e] = bf_lo(cc[e]) * bf_lo(ch[e]); z0[2 * e + 1] = bf_hi(cc[e]) * bf_hi(ch[e]); }
#pragma unroll
            for (int e = 0; e < 4; ++e) { y[2 * e] = bf_lo(cb[e]) * (w[0][2 * e] * z2[2 * e] + w[1][2 * e] * z1[2 * e] + w[2][2 * e] * z0[2 * e]);
                y[2 * e + 1] = bf_hi(cb[e]) * (w[0][2 * e + 1] * z2[2 * e + 1] + w[1][2 * e + 1] * z1[2 * e + 1] + w[2][2 * e + 1] * z0[2 * e + 1]); }
            u32x4 o;
#pragma unroll
            for (int e = 0; e < 4; ++e) o[e] = pk2(y[2 * e], y[2 * e + 1]);
            *(u32x4*)(outp + (size_t)t * D + 512 + c0) = o;
#pragma unroll
            for (int e = 0; e < 8; ++e) { z2[e] = z1[e]; z1[e] = z0[e]; } }
    }
}
__device__ __forceinline__ void phase_mixer(Frame& F, int l) {
    rebind(F);
    const int nm = F.G > 64 ? 64 : 0;
#ifdef MIXER_NAIVE
    if (nm) { if (F.bid < 64) mlstm_naive_unit(F, l, F.bid); else conv_items(F, l, 64, F.G - 64); }
    else { for (int u = F.bid; u < 64; u += F.G) mlstm_naive_unit(F, l, u); conv_items(F, l, 0, F.G); }
#else
    if (nm) { if (F.bid < 64) mlstm_chunk_unit(F, l, F.bid); else conv_items(F, l, 64, F.G - 64); }
    else { for (int u = F.bid; u < 64; u += F.G) { mlstm_chunk_unit(F, l, u); __syncthreads(); } conv_items(F, l, 0, F.G); }
#endif
}

__device__ __forceinline__ int moe_tables(Frame& F, int l) {
    LAS int* tcls = (LAS int*)(F.lds + MISC_OFF + MO_TCLS); LAS int* ttb = (LAS int*)(F.lds + MISC_OFF + MO_TTB); LAS int* cnts = (LAS int*)(F.lds + MISC_OFF + MO_CNT); LAS int* ntp = (LAS int*)(F.lds + MISC_OFF + MO_NT);
    __syncthreads();
    if (F.tid == 0) { int t = 0;
        for (int c = 0; c < NCLS; ++c) { int n = (int)__hip_atomic_load(F.ctl + CW_CNT + l * 32 + c, RLX_AGENT); if (n > CLS_CAP) n = CLS_CAP; cnts[c] = n;
            for (int j = 0; j * 256 < n && t < MAXTILES; ++j) { tcls[t] = c; ttb[t] = j * 256; ++t; } }
        ntp[0] = t; }
    __syncthreads();
    return ntp[0];
}
__device__ __forceinline__ void phase_moe_gu(Frame& F, int l) {
    rebind(F);
    const int NT = moe_tables(F, l);
    PolMoeGU P; P.tcls = (const LAS int*)(F.lds + MISC_OFF + MO_TCLS); P.ttb = (const LAS int*)(F.lds + MISC_OFF + MO_TTB); P.cnts = (const LAS int*)(F.lds + MISC_OFF + MO_CNT);
    P.NT = NT; P.G = F.G; P.c = F.bid; P.A = (const char*)(F.ws + WS_UA); P.B = (const char*)(F.ws + WS_WGU) + (size_t)l * 16 * 1024 * 2048; P.ri = (const RInfo*)(F.ws + WS_RINFO); P.H = (bf16*)(F.ws + WS_BIG);
    pg8::gemm_phase<PolMoeGU, true>(F.lds, P);
}
__device__ __forceinline__ void phase_moe_down(Frame& F, int l) {
    rebind(F);
    const int NT = moe_tables(F, l);
    PolMoeDown P; P.tcls = (const LAS int*)(F.lds + MISC_OFF + MO_TCLS); P.ttb = (const LAS int*)(F.lds + MISC_OFF + MO_TTB); P.cnts = (const LAS int*)(F.lds + MISC_OFF + MO_CNT);
    P.NT = NT; P.G = F.G; P.c = F.bid; P.A = (const char*)(F.ws + WS_BIG); P.B = (const char*)(F.ws + WS_WD) + (size_t)l * 16 * 1024 * 1024; P.ri = (const RInfo*)(F.ws + WS_RINFO); P.Y = (bf16*)(F.ws + WS_Y);
    pg8::gemm_phase<PolMoeDown, true>(F.lds, P);
}
__device__ __forceinline__ void phase_inproj(Frame& F, int l) {
    rebind(F);
    PolInProj P; P.so.init(T, DINW, F.G, F.bid); P.A = (const char*)(F.ws + WS_UA); P.B = (const char*)(F.ws + WS_WIN) + (size_t)l * DINW * 2048; P.O = (bf16*)(F.ws + WS_BIG);
    pg8::gemm_phase<PolInProj, true>(F.lds, P);
}
__device__ __forceinline__ void phase_outproj(Frame& F, int l) {
    rebind(F);
    PolOutProj P; P.so.init(T, D, F.G, F.bid); P.A = (const char*)(F.ws + WS_UA); P.B = (const char*)(F.ws + WS_WOUT) + (size_t)l * D * 2048; P.C = (float*)(F.ws + WS_BIG);
    pg8::gemm_phase<PolOutProj, true>(F.lds, P);
}

#include <cstdlib>
#include <vector>

#define XB_TMO      128
#define XB_XCNT(j)  (256  + 64 * (j))
#define XB_XSUB(j)  (1280 + 64 * (j))
#define XB_XGEN(j)  (2304 + 64 * (j))
#define XB_TOP      3328
#define XB_TOPGEN   3392
#define XCD_BAR_WORDS 3456
#define XB_SPIN_CAP (1u << 18)

__device__ __forceinline__ unsigned xb_ld(unsigned* p)              { return __hip_atomic_load(p, __ATOMIC_RELAXED, __HIP_MEMORY_SCOPE_AGENT); }
__device__ __forceinline__ unsigned xb_add(unsigned* p, unsigned v) { return __hip_atomic_fetch_add(p, v, __ATOMIC_RELAXED, __HIP_MEMORY_SCOPE_AGENT); }
__device__ __forceinline__ unsigned xb_xcc_id() { return (unsigned)__builtin_amdgcn_s_getreg((3 << 11) | 20) & 0xFu; }
#define XB_SPIN(cond, bar) do { unsigned _sp = 0; while (cond) { __builtin_amdgcn_s_sleep(1); \
    if ((++_sp & 255u) == 0u) { if (xb_ld(&(bar)[XB_TMO])) break; if (_sp > XB_SPIN_CAP) { atomicAdd(&(bar)[XB_TMO], 1u); break; } } } } while (0)

struct XcdBarrier {
    unsigned* bar; unsigned x;
    volatile LAS unsigned* st;
};

__device__ __forceinline__ XcdBarrier xcd_barrier_post(unsigned* bar, volatile LAS unsigned* st) {
    XcdBarrier b; b.bar = bar; b.x = xb_xcc_id(); b.st = st;
    if (threadIdx.x == 0) (void)xb_add(&bar[XB_XCNT(b.x)], 1u);
    return b;
}
__device__ __forceinline__ void xcd_barrier_complete(unsigned* bar, unsigned x, unsigned& nloc, unsigned& nx) {
    const unsigned G = gridDim.x * gridDim.y * gridDim.z;
    unsigned sum, cnt, mine, sp = 0u;
    for (;;) {
        sum = 0u; cnt = 0u; mine = 0u;
#pragma unroll
        for (unsigned j = 0; j < 16; ++j) { const unsigned c = xb_ld(&bar[XB_XCNT(j)]); sum += c; cnt += (c > 0u) ? 1u : 0u; mine = (j == x) ? c : mine; }
        if (sum == G) break;
        __builtin_amdgcn_s_sleep(1);
        if ((++sp & 255u) == 0u) { if (xb_ld(&bar[XB_TMO])) break; if (sp > XB_SPIN_CAP) { atomicAdd(&bar[XB_TMO], 1u); break; } }
    }
    nloc = mine > 0u ? mine : 1u; nx = cnt > 0u ? cnt : 1u;
}

__device__ __forceinline__ void xcd_barrier(const XcdBarrier& b) {
    asm volatile("s_waitcnt vmcnt(0)" ::: "memory");
    __syncthreads();
    if (threadIdx.x == 0) {
        unsigned* bar = b.bar;
        __builtin_amdgcn_s_waitcnt(0);
        unsigned nloc = b.st[0], nx = b.st[1];
        if (nloc == 0u) { xcd_barrier_complete(bar, b.x, nloc, nx); b.st[0] = nloc; b.st[1] = nx; }
        const unsigned old = xb_add(&bar[XB_XSUB(b.x)], 1u);
        const unsigned gen = old / nloc;
        if (old + 1u == (gen + 1u) * nloc) {
            __builtin_amdgcn_fence(__ATOMIC_RELEASE, "agent");
            asm volatile("s_waitcnt vmcnt(0)" ::: "memory");
            const unsigned og = xb_add(&bar[XB_TOP], 1u);
            const unsigned tg = og / nx;
            if (og + 1u == (tg + 1u) * nx) xb_add(&bar[XB_TOPGEN], 1u);
            else XB_SPIN(xb_ld(&bar[XB_TOPGEN]) == tg, bar);
            __builtin_amdgcn_fence(__ATOMIC_ACQUIRE, "agent");
            xb_add(&bar[XB_XGEN(b.x)], 1u);
            asm volatile("s_waitcnt vmcnt(0)" ::: "memory");
        } else {
            XB_SPIN(xb_ld(&bar[XB_XGEN(b.x)]) == gen, bar);
            __builtin_amdgcn_fence(__ATOMIC_ACQUIRE, "agent");
            asm volatile("s_waitcnt vmcnt(0)" ::: "memory");
        }
    }
    __syncthreads();
}

enum { PH_PRO = 0, PH_ROWA, PH_INPROJ, PH_MIXER, PH_OUTPROJ, PH_ROWB, PH_MOEGU, PH_MOEDOWN, PH_ROWC };
#ifndef MK_N_LAUNCHES
#define MK_N_LAUNCHES 1
#endif
__device__ __forceinline__ void frame_init(Frame& F, const Args& args, unsigned char* lds) {
    F.lds = (LAS unsigned char*)lds; F.ws = F.ws0 = args.ws; F.ctl = (gu32*)(args.ws + WS_CTL); F.out = F.out0 = args.out;
    F.ap = (KArgs)__builtin_amdgcn_kernarg_segment_ptr();
    F.tid = threadIdx.x; F.lane = F.tid & 63; F.wave = __builtin_amdgcn_readfirstlane(F.tid >> 6); F.G = gridDim.x;
}
#if MK_N_LAUNCHES == 1
__global__ void __launch_bounds__(NTHR, 2) fwd(Args args) {
    extern __shared__ __attribute__((aligned(16))) unsigned char lds[];
    Frame F; frame_init(F, args, lds);
    for (int u = F.tid; u < (LDS_BYTES - MISC_OFF) / 4; u += NTHR) ((LAS unsigned*)(F.lds + MISC_OFF))[u] = 0u;
    __syncthreads();
    const XcdBarrier bar = xcd_barrier_post((unsigned*)(args.ws + WS_CTL) + CW_BAR, (volatile LAS unsigned*)(F.lds + MISC_OFF + MO_BAR));
#define GRID_BAR() do { XcdBarrier bb_ = bar; size_t zo_ = 0; asm volatile("" : "+s"(zo_), "+s"(bb_.x)); bb_.bar = bar.bar + zo_; xcd_barrier(bb_); } while (0)
    phase_prologue(F); GRID_BAR();
    phase_rowA(F); GRID_BAR();
    static_assert(NL == 2, "two layers written out (no runtime layer loop: nothing to hoist out of it)");
#define LAYER(l, LASTL) do { phase_inproj(F, l); GRID_BAR(); phase_mixer(F, l); GRID_BAR(); phase_outproj(F, l); GRID_BAR(); phase_rowB(F, l); GRID_BAR(); \
        phase_moe_gu(F, l); GRID_BAR(); phase_moe_down(F, l); GRID_BAR(); phase_rowC(F, l); if (!(LASTL)) GRID_BAR(); } while (0)
    LAYER(0, false);
    LAYER(1, true);
#undef LAYER
}
#else
template <int PH>
__global__ void __launch_bounds__(NTHR, 2) k_phase(Args args) {
    extern __shared__ __attribute__((aligned(16))) unsigned char lds[];
    Frame F; frame_init(F, args, lds);
    const int l = args.l;
    if constexpr (PH == PH_PRO) phase_prologue(F);
    if constexpr (PH == PH_ROWA) phase_rowA(F);
    if constexpr (PH == PH_INPROJ) phase_inproj(F, l);
    if constexpr (PH == PH_MIXER) phase_mixer(F, l);
    if constexpr (PH == PH_OUTPROJ) phase_outproj(F, l);
    if constexpr (PH == PH_ROWB) phase_rowB(F, l);
    if constexpr (PH == PH_MOEGU) phase_moe_gu(F, l);
    if constexpr (PH == PH_MOEDOWN) phase_moe_down(F, l);
    if constexpr (PH == PH_ROWC) phase_rowC(F, l);
}
template <int PH> static bool launch_phase(const Args& a, int grid, hipStream_t stream) {
    static bool attr = false;
    if (!attr) { if (hipFuncSetAttribute((const void*)k_phase<PH>, hipFuncAttributeMaxDynamicSharedMemorySize, LDS_BYTES) != hipSuccess) { fprintf(stderr, "kernel_launch: hipFuncSetAttribute failed (phase %d)\n", PH); return false; } attr = true; }
    hipLaunchKernelGGL(k_phase<PH>, dim3(grid), dim3(NTHR), LDS_BYTES, stream, a);
    const hipError_t le = hipPeekAtLastError();
    if (le != hipSuccess) { fprintf(stderr, "kernel_launch: launch of phase %d failed: %s\n", PH, hipGetErrorName(le)); return false; }
    return true;
}
#endif

extern "C" void kernel_launch(void* const* d_in, const int* in_sizes, int n_in, void* d_out, int out_size, void* d_ws, size_t ws_size, hipStream_t stream) {
    static int grid = 0;
    if (grid == 0) {
        if (n_in != 20 || in_sizes[0] != T * D || out_size != T * D || ws_size < WS_END) { fprintf(stderr, "kernel_launch: unexpected shapes (n_in %d, in0 %d, out %d, ws %zu < %zu)\n", n_in, n_in > 0 ? in_sizes[0] : -1, out_size, ws_size, (size_t)WS_END); grid = -1; return; }
        int dev = 0, cus = 0;
        if (hipGetDevice(&dev) != hipSuccess || hipDeviceGetAttribute(&cus, hipDeviceAttributeMultiprocessorCount, dev) != hipSuccess) { grid = -1; return; }
#if MK_N_LAUNCHES == 1
        if (hipFuncSetAttribute((const void*)fwd, hipFuncAttributeMaxDynamicSharedMemorySize, LDS_BYTES) != hipSuccess) { fprintf(stderr, "kernel_launch: hipFuncSetAttribute failed\n"); grid = -1; return; }
        int per_cu = 0;
        if (hipOccupancyMaxActiveBlocksPerMultiprocessor(&per_cu, (const void*)fwd, NTHR, LDS_BYTES) != hipSuccess || per_cu < 1) { fprintf(stderr, "kernel_launch: occupancy query reports %d workgroups per CU; nothing launched\n", per_cu); grid = -1; return; }
        (void)hipGetLastError();
#endif
        grid = cus;
    }
    if (grid < 0) return;
    if (hipMemsetAsync((char*)d_ws + WS_CTL, 0, CTL_ZERO_BYTES, stream) != hipSuccess) return;
    Args a{};
    for (int i = 0; i < 20; ++i) a.in[i] = (const float*)d_in[i];
    a.out = (float*)d_out; a.ws = (unsigned char*)d_ws; a.l = 0; a.pad = 0;
#if MK_N_LAUNCHES == 1
    hipLaunchKernelGGL(fwd, dim3(grid), dim3(NTHR), LDS_BYTES, stream, a);
    const hipError_t le = hipPeekAtLastError();
    if (le != hipSuccess) fprintf(stderr, "kernel_launch: launch failed: %s\n", hipGetErrorName(le));
#else
#define LP(PH) do { if (!launch_phase<PH>(a, grid, stream)) return; } while (0)
    LP(PH_PRO);
    LP(PH_ROWA);
    for (int l = 0; l < NL; ++l) {
        a.l = l;
        LP(PH_INPROJ); LP(PH_MIXER); LP(PH_OUTPROJ); LP(PH_ROWB); LP(PH_MOEGU); LP(PH_MOEDOWN); LP(PH_ROWC);
    }
#endif
}
```

```cpp
#include <hip/hip_runtime.h>
#include <cstdio>
#include <cstdint>

#define GAS __attribute__((address_space(1)))
#define LAS __attribute__((address_space(3)))
typedef unsigned short bf16;
typedef short bf16x8 __attribute__((ext_vector_type(8)));
typedef float f32x4 __attribute__((ext_vector_type(4)));
typedef float f32x2 __attribute__((ext_vector_type(2)));
typedef unsigned u32x4 __attribute__((ext_vector_type(4)));
typedef unsigned u32x2 __attribute__((ext_vector_type(2)));
typedef GAS unsigned gu32;
#define RLX_AGENT __ATOMIC_RELAXED, __HIP_MEMORY_SCOPE_AGENT
#define LDS_WAIT() asm volatile("s_waitcnt lgkmcnt(0)" ::: "memory")
#define VM_WAIT() asm volatile("s_waitcnt vmcnt(0)" ::: "memory")

constexpr int T = 32768, D = 1024, SEQ = 2048, NL = 2, DINW = 3584, DIN_SRC = 3592;
constexpr int NCLS = 24, CLS_CAP = 32768, MAXTILES = 160;
constexpr float ALPHA = 1.41421356237309505f, LN_EPS = 1e-5f, QSCALE = 0.08838834764831845f;
constexpr int NWAVES = 8, NTHR = 512;

constexpr size_t MiB = 1u << 20;
constexpr size_t WS_CTL = 0, CTL_ZERO_BYTES = 1 * MiB;
constexpr size_t WS_MOD = 1 * MiB;
constexpr size_t WS_GATES = 2 * MiB;
constexpr size_t WS_RINFO = 4 * MiB;
constexpr size_t WS_WIN = 16 * MiB;
constexpr size_t WS_WOUT = 30 * MiB;
constexpr size_t WS_WGU = 34 * MiB;
constexpr size_t WS_WD = 98 * MiB;
constexpr size_t WS_UA = 130 * MiB;
constexpr size_t WS_BIG = 194 * MiB;
constexpr size_t WS_X1 = WS_BIG + 128 * MiB;
constexpr size_t WS_Y = WS_UA;
constexpr size_t WS_CST = WS_BIG + 224 * MiB;
constexpr size_t WS_NPREV = WS_CST + 64 * MiB;
constexpr size_t WS_MST = WS_NPREV + 1 * MiB;
constexpr size_t WS_END = WS_MST + 1 * MiB;
static_assert(WS_END <= 512 * MiB, "d_ws is 512 MiB");
static_assert((size_t)(T + NCLS * 256) * 1024 * 2 <= 128 * MiB, "HID fits below X1");
constexpr int CW_TMO = 0, CW_CODE = 1, CW_CNT = 64, CW_BAR = 4096;

constexpr int RING_BYTES = 131072, MISC_OFF = RING_BYTES, LDS_BYTES = 147456;
constexpr int MO_BAR = 0, MO_TCLS = 64, MO_TTB = 1024, MO_CNT = 2048, MO_NT = 2176, MO_LCNT = 2304, MO_LBASE = 2432, MO_REC = 4096, MO_SG = 8192;

struct RInfo { int token; float wa; float wb; int pad; };

__device__ __forceinline__ unsigned f2bf(float f) { unsigned u = __builtin_bit_cast(unsigned, f); return (u + 0x7fffu + ((u >> 16) & 1u)) >> 16; }
__device__ __forceinline__ unsigned pk2(float lo, float hi) { return f2bf(lo) | (f2bf(hi) << 16); }
__device__ __forceinline__ float bf_lo(unsigned w) { return __builtin_bit_cast(float, w << 16); }
__device__ __forceinline__ float bf_hi(unsigned w) { return __builtin_bit_cast(float, w & 0xffff0000u); }
__device__ __forceinline__ float wave_sum(float v) {
#pragma unroll
    for (int o = 1; o < 64; o <<= 1) v += __shfl_xor(v, o);
    return v;
}
__device__ __forceinline__ float sigmoidf_(float x) { return 1.0f / (1.0f + __expf(-x)); }

__device__ __forceinline__ int opaque_tid() {
    int w = __builtin_amdgcn_readfirstlane(threadIdx.x >> 6); asm volatile("" : "+s"(w));
    int l = __builtin_amdgcn_mbcnt_hi(~0u, __builtin_amdgcn_mbcnt_lo(~0u, 0u)); asm volatile("" : "+v"(l));
    return w * 64 + l; }
namespace pg8 {
constexpr int BM = 256, BK = 64, HALF = 128, HTB = HALF * BK * 2, STAGE_BYTES = 8 * HTB, NXCD = 8, WGM = 8;
__host__ __device__ __forceinline__ int lds_byte(int r, int c) { const int st = (r >> 4) * 2 + (c >> 5), rr = r & 15, cc = c & 31, ob = rr * 64 + cc * 2; return st * 1024 + (ob ^ (((ob >> 9) & 1) << 5)); }
__host__ __device__ __forceinline__ void stage_rc(int b, int& R, int& C) { const int st = b / 1024, sb = b % 1024, swz = sb ^ (((sb >> 9) & 1) << 5); R = (st >> 1) * 16 + swz / 64; C = (st & 1) * 32 + (swz % 64) / 2; }
__host__ __device__ __forceinline__ int perm32(int rho) { const int n = rho >> 4, i = rho & 15; return 8 * (i >> 2) + 4 * n + (i & 3); }
__device__ __forceinline__ unsigned cvt_pk_bf16(float lo, float hi) { unsigned r; asm volatile("v_cvt_pk_bf16_f32 %0, %1, %2" : "=v"(r) : "v"(lo), "v"(hi)); return r; }

__device__ __forceinline__ void stage_rows(int (&sR)[2], int (&sC)[2]) { const int tid = opaque_tid();
#pragma unroll
    for (int i = 0; i < 2; ++i) stage_rc(tid * 16 + i * 8192, sR[i], sC[i]); }
struct StaticOrder {
    int nM, nN, nwg, G, c;
    __device__ void init(int M, int N, int G_, int c_) { nM = M / BM; nN = N / BM; nwg = nM * nN; G = G_; c = c_; }
    __device__ bool next(int i, int& pm, int& pn) const {
        const long L = (long)i * G + c; if (L >= nwg) return false;
        int wgid = (int)L; { const int q = nwg / NXCD, r = nwg % NXCD, xcd = wgid % NXCD, off = wgid / NXCD; wgid = (xcd < r ? xcd * (q + 1) : r * (q + 1) + (xcd - r) * q) + off; }
        const int nig = WGM * nN, gid = wgid / nig, fm = gid * WGM, gsz = (nM - fm) < WGM ? (nM - fm) : WGM;
        pm = fm + ((wgid % nig) % gsz); pn = (wgid % nig) / gsz; return true;
    }
};

template <class P, bool ALIGN_EPI>
__device__ __forceinline__ void gemm_phase(LAS unsigned char* lds, const P& S) {
    const int tid = opaque_tid(), wid = __builtin_amdgcn_readfirstlane(tid >> 6), lane = tid & 63, wr = wid >> 2, wc = wid & 3, fr = lane & 15, fq = lane >> 4;
    constexpr int nt = 16;
    unsigned voffB[2];
#pragma unroll
    for (int i = 0; i < 2; ++i) { int R, C; stage_rc(tid * 16 + i * 8192, R, C); const int Rb = P::PERM ? ((R & ~31) + perm32(R & 31)) : R; voffB[i] = (unsigned)(Rb * P::LDB + C) * 2u; }
    constexpr size_t kstep = (size_t)(BK * 2);
    constexpr size_t hstepB = (size_t)HALF * P::LDB * 2;
    const unsigned ldsw = (unsigned)wid * 1024u;
    const int aoff = lds_byte(wr * 64 + fr, fq * 8), boff = lds_byte(wc * 32 + fr, fq * 8);
#define PG8_SA(b, h) (((b) * 2 + (h)) * HTB)
#define PG8_SB(b, h) ((4 + (b) * 2 + (h)) * HTB)
#define PG8_STAGE(bufoff, gbase, voff) do { _Pragma("unroll") for (int _i = 0; _i < 2; ++_i) \
        __builtin_amdgcn_global_load_lds((const unsigned*)((const char*)(gbase) + (voff)[_i]), (LAS unsigned*)(lds + (bufoff) + ldsw + _i * 8192), 16, 0, 0); } while (0)
#define PG8_LDA(dst, b, h) do { _Pragma("unroll") for (int m = 0; m < 4; ++m) _Pragma("unroll") for (int k = 0; k < 2; ++k) dst[m][k] = *(const LAS bf16x8*)(lds + PG8_SA(b, h) + aoff + m * 2048 + k * 1024); } while (0)
#define PG8_LDB(dst, b, h) do { _Pragma("unroll") for (int n = 0; n < 2; ++n) _Pragma("unroll") for (int k = 0; k < 2; ++k) dst[n][k] = *(const LAS bf16x8*)(lds + PG8_SB(b, h) + boff + n * 2048 + k * 1024); } while (0)
#define PG8_MMA(ai, bj, At, Bt) do { __builtin_amdgcn_s_setprio(1); _Pragma("unroll") for (int m = 0; m < 4; ++m) _Pragma("unroll") for (int n = 0; n < 2; ++n) _Pragma("unroll") for (int k = 0; k < 2; ++k) \
        acc[ai][bj][m][n] = __builtin_amdgcn_mfma_f32_16x16x32_bf16(Bt[n][k], At[m][k], acc[ai][bj][m][n], 0, 0, 0); __builtin_amdgcn_s_setprio(0); } while (0)
#define PG8_WAIT_V(n) asm volatile("s_waitcnt vmcnt(" #n ")" ::: "memory")
#define PG8_WAIT_L(n) asm volatile("s_waitcnt lgkmcnt(" #n ")" ::: "memory")
#define PG8_BAR __builtin_amdgcn_s_barrier()
#define PG8_SCHED __builtin_amdgcn_sched_barrier(0)
    typename P::U cur, nxt; int ui = 0;
    if (!S.next(0, cur)) return;
    f32x4 acc[2][2][4][2];
#pragma unroll
    for (int a = 0; a < 2; ++a)
#pragma unroll
        for (int b = 0; b < 2; ++b)
#pragma unroll
            for (int m = 0; m < 4; ++m)
#pragma unroll
                for (int n = 0; n < 2; ++n) acc[a][b][m][n] = (f32x4){0.f, 0.f, 0.f, 0.f};
    bf16x8 At[4][2], B0[2][2], B1[2][2];
    unsigned offC[2][2];
    S.a_off(cur, offC);
    const char* cA = S.a_base(cur); const char* cB = S.b_base(cur, 0);
    PG8_STAGE(PG8_SB(0, 0), cB, voffB); PG8_STAGE(PG8_SB(0, 1), cB + hstepB, voffB); PG8_STAGE(PG8_SA(0, 0), cA, offC[0]); PG8_STAGE(PG8_SA(0, 1), cA, offC[1]);
    if (wr == 1) PG8_BAR;
    PG8_WAIT_V(2); PG8_BAR;
    PG8_STAGE(PG8_SB(1, 0), cB + kstep, voffB); PG8_STAGE(PG8_SA(1, 0), cA + kstep, offC[0]); PG8_STAGE(PG8_SB(1, 1), cB + hstepB + kstep, voffB);
    PG8_WAIT_V(6); PG8_BAR;
    for (;;) {
        const bool has_next = S.next(ui + 1, nxt);
        const char* nA = cA; const char* nB = cB;
        if (has_next) { nA = S.a_base(nxt); nB = S.b_base(nxt, 0); }
        unsigned o2[2][2];
#pragma nounroll
        for (int t = 0; t < nt; t += 2) {
            const bool last = (t == nt - 2);
            const char* a1 = cA + (size_t)(t + 1) * kstep;
            const char* a2 = last ? nA : cA + (size_t)(t + 2) * kstep; const char* b2 = last ? nB : S.b_base(cur, t + 2);
            const char* a3 = a2 + kstep; const char* b3 = b2 + kstep;
            if (P::GATHER && last && has_next) S.a_off(nxt, o2);
            else {
#pragma unroll
                for (int h = 0; h < 2; ++h)
#pragma unroll
                    for (int i = 0; i < 2; ++i) o2[h][i] = offC[h][i]; }
            PG8_LDB(B0, 0, 0); PG8_LDB(B1, 0, 1); PG8_SCHED; PG8_LDA(At, 0, 0); PG8_STAGE(PG8_SA(1, 1), a1, offC[1]);
            PG8_WAIT_V(8); PG8_WAIT_L(0); PG8_BAR; PG8_MMA(0, 0, At, B0); PG8_MMA(0, 1, At, B1); PG8_BAR; PG8_SCHED;
            PG8_LDA(At, 0, 1); PG8_STAGE(PG8_SB(0, 0), b2, voffB); PG8_STAGE(PG8_SB(0, 1), b2 + hstepB, voffB); PG8_STAGE(PG8_SA(0, 0), a2, o2[0]);
            PG8_WAIT_V(8); PG8_WAIT_L(0); PG8_BAR; PG8_MMA(1, 0, At, B0); PG8_MMA(1, 1, At, B1); PG8_BAR; PG8_SCHED;
            PG8_LDB(B0, 1, 0); PG8_LDB(B1, 1, 1); PG8_SCHED; PG8_LDA(At, 1, 0); PG8_STAGE(PG8_SA(0, 1), a2, o2[1]);
            PG8_WAIT_V(8); PG8_WAIT_L(0); PG8_BAR; PG8_MMA(0, 0, At, B0); PG8_MMA(0, 1, At, B1); PG8_BAR; PG8_SCHED;
            PG8_LDA(At, 1, 1); PG8_STAGE(PG8_SB(1, 0), b3, voffB); PG8_STAGE(PG8_SB(1, 1), b3 + hstepB, voffB); PG8_STAGE(PG8_SA(1, 0), a3, o2[0]);
            PG8_WAIT_V(8); PG8_WAIT_L(0); PG8_BAR; PG8_MMA(1, 0, At, B0); PG8_MMA(1, 1, At, B1); PG8_BAR; PG8_SCHED;
        }
        if constexpr (ALIGN_EPI) { if (wr == 0) PG8_BAR; }
        S.epi(acc, cur, wr, wc, fr, fq);
        if (!has_next) break;
#pragma unroll
        for (int a = 0; a < 2; ++a)
#pragma unroll
            for (int b = 0; b < 2; ++b)
#pragma unroll
                for (int m = 0; m < 4; ++m)
#pragma unroll
                    for (int n = 0; n < 2; ++n) acc[a][b][m][n] = (f32x4){0.f, 0.f, 0.f, 0.f};
        cur = nxt; cA = nA; cB = nB; ++ui;
        if constexpr (P::GATHER) {
#pragma unroll
            for (int h = 0; h < 2; ++h)
#pragma unroll
                for (int i = 0; i < 2; ++i) offC[h][i] = o2[h][i]; }
        if constexpr (ALIGN_EPI) { if (wr == 1) PG8_BAR; }
    }
    PG8_WAIT_V(0);
    if constexpr (!ALIGN_EPI) { if (wr == 0) PG8_BAR; }
    PG8_BAR;
#undef PG8_SA
#undef PG8_SB
#undef PG8_STAGE
#undef PG8_LDA
#undef PG8_LDB
#undef PG8_MMA
#undef PG8_WAIT_V
#undef PG8_WAIT_L
#undef PG8_BAR
#undef PG8_SCHED
}
}

struct Args { const float* in[20]; float* out; unsigned char* ws; int l, pad; };
struct ArgsG { const GAS float* in[20]; float* out; unsigned char* ws; int l, pad; };
typedef __attribute__((address_space(4))) const ArgsG* KArgs;
typedef const GAS float* gin;
struct Frame {
    LAS unsigned char* lds;
    gu32* ctl;
    unsigned char* ws; unsigned char* ws0;
    KArgs ap;
    float* out; float* out0;
    int tid, lane, wave, G, bid;
    __device__ __forceinline__ gin in(int i) const { return ap->in[i]; }
};
__device__ __forceinline__ void rebind(Frame& F) {
    F.tid = opaque_tid(); F.lane = F.tid & 63; F.wave = __builtin_amdgcn_readfirstlane(F.tid >> 6);
    KArgs ap = (KArgs)__builtin_amdgcn_kernarg_segment_ptr(); asm volatile("" : "+s"(ap)); F.ap = ap;
    size_t z = 0; asm volatile("" : "+s"(z));
    F.ws = F.ws0 + z; F.ctl = (gu32*)(F.ws + WS_CTL); F.out = F.out0 + z;
    int g = gridDim.x; asm volatile("" : "+s"(g)); F.G = g;
    int b = blockIdx.x; asm volatile("" : "+s"(b)); F.bid = b;
}
enum { I_X = 0, I_C, I_WADA, I_BADA, I_WIN, I_BG, I_MHW, I_WCONV, I_WOUT, I_LN1G, I_LN1B, I_WGRP, I_BGRP, I_WR, I_BR, I_WGATE, I_WUP, I_WDOWN, I_LN2G, I_LN2B };

struct UnitS { int pm, pn; };
struct PolInProj {
    typedef UnitS U; static constexpr bool PERM = true, GATHER = false; static constexpr int LDB = 1024;
    pg8::StaticOrder so; const char* A; const char* B; bf16* O;
    __device__ __forceinline__ bool next(int i, U& u) const { return so.next(i, u.pm, u.pn); }
    __device__ __forceinline__ const char* a_base(const U& u) const { return A + (size_t)u.pm * (256 * 2048); }
    __device__ __forceinline__ void a_off(const U&, unsigned (&o)[2][2]) const { int sR[2], sC[2]; pg8::stage_rows(sR, sC);
#pragma unroll
        for (int h = 0; h < 2; ++h)
#pragma unroll
            for (int i = 0; i < 2; ++i) o[h][i] = (unsigned)((h * 128 + sR[i]) * 1024 + sC[i]) * 2u; }
    __device__ __forceinline__ const char* b_base(const U& u, int kt) const { return B + (size_t)u.pn * (256 * 2048) + (size_t)kt * 128; }
    __device__ __forceinline__ void epi(const f32x4 (&acc)[2][2][4][2], const U& u, int wr, int wc, int fr, int fq) const {
        const int row0 = u.pm * 256 + wr * 64 + fr, col0 = u.pn * 256 + wc * 32 + 8 * fq;
#pragma unroll
        for (int ai = 0; ai < 2; ++ai)
#pragma unroll
            for (int m = 0; m < 4; ++m) { bf16* rowp = O + (size_t)(row0 + ai * 128 + m * 16) * DINW + col0;
#pragma unroll
                for (int bj = 0; bj < 2; ++bj) { const f32x4 v0 = acc[ai][bj][m][0], v1 = acc[ai][bj][m][1];
                    u32x4 w; w.x = pg8::cvt_pk_bf16(v0[0], v0[1]); w.y = pg8::cvt_pk_bf16(v0[2], v0[3]); w.z = pg8::cvt_pk_bf16(v1[0], v1[1]); w.w = pg8::cvt_pk_bf16(v1[2], v1[3]);
                    *(u32x4*)(rowp + bj * 128) = w; } }
    }
};
struct PolOutProj {
    typedef UnitS U; static constexpr bool PERM = true, GATHER = false; static constexpr int LDB = 1024;
    pg8::StaticOrder so; const char* A; const char* B; bf16* C;
    __device__ __forceinline__ bool next(int i, U& u) const { return so.next(i, u.pm, u.pn); }
    __device__ __forceinline__ const char* a_base(const U& u) const { return A + (size_t)u.pm * (256 * 2048); }
    __device__ __forceinline__ void a_off(const U&, unsigned (&o)[2][2]) const { int sR[2], sC[2]; pg8::stage_rows(sR, sC);
#pragma unroll
        for (int h = 0; h < 2; ++h)
#pragma unroll
            for (int i = 0; i < 2; ++i) o[h][i] = (unsigned)((h * 128 + sR[i]) * 1024 + sC[i]) * 2u; }
    __device__ __forceinline__ const char* b_base(const U& u, int kt) const { return B + (size_t)u.pn * (256 * 2048) + (size_t)kt * 128; }
    __device__ __forceinline__ void epi(const f32x4 (&acc)[2][2][4][2], const U& u, int wr, int wc, int fr, int fq) const {
        const int row0 = u.pm * 256 + wr * 64 + fr, col0 = u.pn * 256 + wc * 32 + 8 * fq;
#pragma unroll
        for (int ai = 0; ai < 2; ++ai)
#pragma unroll
            for (int m = 0; m < 4; ++m) { bf16* rowp = C + (size_t)(row0 + ai * 128 + m * 16) * D + col0;
#pragma unroll
                for (int bj = 0; bj < 2; ++bj) { const f32x4 v0 = acc[ai][bj][m][0], v1 = acc[ai][bj][m][1];
                    u32x4 w; w.x = pg8::cvt_pk_bf16(v0[0], v0[1]); w.y = pg8::cvt_pk_bf16(v0[2], v0[3]); w.z = pg8::cvt_pk_bf16(v1[0], v1[1]); w.w = pg8::cvt_pk_bf16(v1[2], v1[3]);
                    *(u32x4*)(rowp + bj * 128) = w; } }
    }
};
struct UnitM { int tile, pn, cls, tb, cnt; };
__device__ __forceinline__ int pair_a(int p) { return p < 3 ? 0 : (p < 5 ? 1 : 2); }
__device__ __forceinline__ int pair_b(int p) { return p < 3 ? p + 1 : (p < 5 ? p - 1 : 3); }
struct PolMoeGU {
    typedef UnitM U; static constexpr bool PERM = true, GATHER = true; static constexpr int LDB = 1024;
    const LAS int* tcls; const LAS int* ttb; const LAS int* cnts; int NT, G, c;
    const char* A; const char* B  ; const RInfo* ri; bf16* H;
    __device__ __forceinline__ bool next(int i, U& u) const { const int L = i * G + c; const int tile = L >> 3; if (tile >= NT) return false;
        u.tile = tile; u.pn = L & 7; u.cls = tcls[tile]; u.tb = ttb[tile]; u.cnt = cnts[u.cls]; return true; }
    __device__ __forceinline__ const char* a_base(const U&) const { return A; }
    __device__ __forceinline__ void a_off(const U& u, unsigned (&o)[2][2]) const { int sR[2], sC[2]; pg8::stage_rows(sR, sC);
#pragma unroll
        for (int h = 0; h < 2; ++h)
#pragma unroll
            for (int i = 0; i < 2; ++i) { int rr = u.tb + h * 128 + sR[i]; if (rr >= u.cnt) rr = 0; const int tok = ri[(size_t)u.cls * CLS_CAP + rr].token; o[h][i] = (unsigned)tok * 2048u + (unsigned)sC[i] * 2u; } }
    __device__ __forceinline__ const char* b_base(const U& u, int kt) const { const int g = u.cls / 6, p = u.cls - g * 6, e = (u.pn >> 2) ? pair_b(p) : pair_a(p);
        return B + ((size_t)(g * 4 + e) * 1024 + (size_t)(u.pn & 3) * 256) * 2048 + (size_t)kt * 128; }
    __device__ __forceinline__ void epi(const f32x4 (&acc)[2][2][4][2], const U& u, int wr, int wc, int fr, int fq) const {
        const int slot = u.pn >> 2, ct = u.pn & 3;
#pragma unroll
        for (int ai = 0; ai < 2; ++ai)
#pragma unroll
            for (int m = 0; m < 4; ++m) { const int r = ai * 128 + wr * 64 + m * 16 + fr, rr = u.tb + r; const bool valid = rr < u.cnt;
                float w = 0.f; if (valid) { const RInfo* q = ri + (size_t)u.cls * CLS_CAP + rr; w = slot ? q->wb : q->wa; }
                float hv[8];
#pragma unroll
                for (int n = 0; n < 2; ++n)
#pragma unroll
                    for (int j = 0; j < 4; ++j) { const float g = acc[ai][0][m][n][j], up = acc[ai][1][m][n][j]; hv[n * 4 + j] = g * __builtin_amdgcn_rcpf(1.0f + __expf(-g)) * up * w; }
                u32x4 o; o.x = pg8::cvt_pk_bf16(hv[0], hv[1]); o.y = pg8::cvt_pk_bf16(hv[2], hv[3]); o.z = pg8::cvt_pk_bf16(hv[4], hv[5]); o.w = pg8::cvt_pk_bf16(hv[6], hv[7]);
                if (valid) *(u32x4*)(H + (size_t)(u.tile * 256 + r) * 1024 + slot * 512 + ct * 128 + wc * 32 + 8 * fq) = o; }
    }
};
struct PolMoeDown {
    typedef UnitM U; static constexpr bool PERM = true, GATHER = false; static constexpr int LDB = 512;
    const LAS int* tcls; const LAS int* ttb; const LAS int* cnts; int NT, G, c;
    const char* A  ; const char* B  ; const RInfo* ri; bf16* Y;
    __device__ __forceinline__ bool next(int i, U& u) const { const int L = i * G + c; const int tile = L >> 2; if (tile >= NT) return false;
        u.tile = tile; u.pn = L & 3; u.cls = tcls[tile]; u.tb = ttb[tile]; u.cnt = cnts[u.cls]; return true; }
    __device__ __forceinline__ const char* a_base(const U& u) const { return A + (size_t)u.tile * (256 * 2048); }
    __device__ __forceinline__ void a_off(const U&, unsigned (&o)[2][2]) const { int sR[2], sC[2]; pg8::stage_rows(sR, sC);
#pragma unroll
        for (int h = 0; h < 2; ++h)
#pragma unroll
            for (int i = 0; i < 2; ++i) o[h][i] = (unsigned)((h * 128 + sR[i]) * 1024 + sC[i]) * 2u; }
    __device__ __forceinline__ const char* b_base(const U& u, int kt) const { const int g = u.cls / 6, p = u.cls - g * 6, e = (kt >> 3) ? pair_b(p) : pair_a(p);
        return B + ((size_t)(g * 4 + e) * 1024 + (size_t)u.pn * 256) * 1024 + (size_t)(kt & 7) * 128; }
    __device__ __forceinline__ void epi(const f32x4 (&acc)[2][2][4][2], const U& u, int wr, int wc, int fr, int fq) const {
#pragma unroll
        for (int ai = 0; ai < 2; ++ai)
#pragma unroll
            for (int m = 0; m < 4; ++m) { const int r = ai * 128 + wr * 64 + m * 16 + fr, rr = u.tb + r; const bool valid = rr < u.cnt;
                if (valid) { const int tok = ri[(size_t)u.cls * CLS_CAP + rr].token; bf16* rowp = Y + (size_t)tok * D + u.pn * 256 + wc * 32 + 8 * fq;
#pragma unroll
                    for (int bj = 0; bj < 2; ++bj) { const f32x4 v0 = acc[ai][bj][m][0], v1 = acc[ai][bj][m][1];
                        u32x4 w; w.x = pg8::cvt_pk_bf16(v0[0], v0[1]); w.y = pg8::cvt_pk_bf16(v0[2], v0[3]); w.z = pg8::cvt_pk_bf16(v1[0], v1[1]); w.w = pg8::cvt_pk_bf16(v1[2], v1[3]);
                        *(u32x4*)(rowp + bj * 128) = w; } } }
    }
};

__device__ __forceinline__ void transpose_item(gin W, int ldw, int k0, int n0, bf16* WT, int ldk, int drow0, float scale, LAS float* scr, int lane) {
#pragma unroll 8
    for (int i = 0; i < 32; ++i) { const int kk = 2 * i + (lane >> 5); scr[kk * 33 + (lane & 31)] = W[(size_t)(k0 + kk) * ldw + n0 + (lane & 31)]; }
    LDS_WAIT(); asm volatile("" ::: "memory");
    const int c = lane & 7;
#pragma unroll
    for (int j = 0; j < 4; ++j) { const int n = (lane >> 3) + 8 * j; const LAS float* s = scr + (8 * c) * 33 + n;
        u32x4 o; o.x = pk2(s[0 * 33] * scale, s[1 * 33] * scale); o.y = pk2(s[2 * 33] * scale, s[3 * 33] * scale); o.z = pk2(s[4 * 33] * scale, s[5 * 33] * scale); o.w = pk2(s[6 * 33] * scale, s[7 * 33] * scale);
        *(u32x4*)(WT + (size_t)(drow0 + n) * ldk + k0 + 8 * c) = o; }
    LDS_WAIT(); asm volatile("" ::: "memory");
}
__device__ __forceinline__ void phase_prologue(Frame& F) {
    rebind(F);
    {
        LAS float* scr = (LAS float*)(F.lds + F.wave * 16384);
        const int gw = F.bid * NWAVES + F.wave, NGW = F.G * NWAVES;
        constexpr int I_IN = NL * 16 * 112, I_OUT = NL * 16 * 32, I_G = NL * 16 * 256, I_DN = NL * 16 * 256;
        constexpr int NITEMS = I_IN + I_OUT + 2 * I_G + I_DN;
        for (int it = gw; it < NITEMS; it += NGW) {
            int r = it;
            if (r < I_IN) { const int l = r / 1792, q = r % 1792, kb = q / 112, nb = q % 112, nd = nb * 32, ns = nd < 2048 ? nd : nd + 8;
                transpose_item(F.in(I_WIN) + (size_t)l * D * DIN_SRC, DIN_SRC, kb * 64, ns, (bf16*)(F.ws + WS_WIN) + (size_t)l * DINW * D, D, nd, nd < 512 ? QSCALE : 1.0f, scr, F.lane); continue; }
            r -= I_IN;
            if (r < I_OUT) { const int l = r / 512, q = r % 512, kb = q / 32, nb = q % 32;
                transpose_item(F.in(I_WOUT) + (size_t)l * D * D, D, kb * 64, nb * 32, (bf16*)(F.ws + WS_WOUT) + (size_t)l * D * D, D, nb * 32, 1.0f, scr, F.lane); continue; }
            r -= I_OUT;
            if (r < 2 * I_G) { const int up = r >= I_G; if (up) r -= I_G; const int mat = r / 256, q = r % 256, kb = q / 16, nb = q % 16, f0 = nb * 32;
                transpose_item(F.in(up ? I_WUP : I_WGATE) + (size_t)mat * D * 512, 512, kb * 64, f0, (bf16*)(F.ws + WS_WGU) + (size_t)mat * 1024 * 1024, 1024, (f0 >> 7) * 256 + (f0 & 127) + (up ? 128 : 0), 1.0f, scr, F.lane); continue; }
            r -= 2 * I_G;
            { const int mat = r / 256, q = r % 256, kb = q / 32, nb = q % 32;
                transpose_item(F.in(I_WDOWN) + (size_t)mat * 512 * D, D, kb * 64, nb * 32, (bf16*)(F.ws + WS_WD) + (size_t)mat * 1024 * 512, 512, nb * 32, 1.0f, scr, F.lane); }
        }
    }
    __syncthreads();
    {
        LAS float* cond = (LAS float*)F.lds;
        LAS float* red = (LAS float*)(F.lds + 65536);
        bool have = false;
        for (int un = F.bid; un < NL * 192; un += F.G) {
            if (!have) { for (int i = F.tid; i < 16 * 1024; i += NTHR) { const float c = F.in(I_C)[i]; cond[i] = c * sigmoidf_(c); } have = true; }
            __syncthreads();
            const int l = un / 192, n0 = (un % 192) * 32, n = F.tid & 31, ks = F.tid >> 5;
            gin W = F.in(I_WADA) + (size_t)l * D * 6144 + n0 + n;
            float acc[16];
#pragma unroll
            for (int b = 0; b < 16; ++b) acc[b] = 0.f;
            for (int kk = 0; kk < 64; ++kk) { const int k = ks * 64 + kk; const float w = W[(size_t)k * 6144];
#pragma unroll
                for (int b = 0; b < 16; ++b) acc[b] += cond[b * 1024 + k] * w; }
#pragma unroll
            for (int b = 0; b < 16; ++b) red[(ks * 16 + b) * 32 + n] = acc[b];
            __syncthreads();
            { const int b = F.tid >> 5; float s = 0.f;
#pragma unroll
              for (int k2 = 0; k2 < 16; ++k2) s += red[(k2 * 16 + b) * 32 + n];
              ((float*)(F.ws + WS_MOD))[((size_t)l * 16 + b) * 6144 + n0 + n] = s + F.in(I_BADA)[l * 6144 + n0 + n]; }
        }
    }
}

__device__ __forceinline__ void stage_cols_T(LAS float* dst, gin src, int ld, int col0, int NC, int tid) {
    for (int idx = tid; idx < NC * 1024; idx += NTHR) { const int k = idx / NC, c = idx - k * NC; dst[c * 1024 + k] = src[(size_t)k * ld + col0 + c]; }
}
__device__ __forceinline__ float dpp_xadd(float v, const int ctrl_is) {
    return v;
}
#define DPP_ADD(v, ctrl) ((v) + __builtin_bit_cast(float, __builtin_amdgcn_update_dpp(0, __builtin_bit_cast(int, (v)), (ctrl), 0xf, 0xf, true)))
__device__ __forceinline__ float wave_sum_dpp(float v) {
    v = DPP_ADD(v, 0xB1);
    v = DPP_ADD(v, 0x4E);
    v = DPP_ADD(v, 0x141);
    v = DPP_ADD(v, 0x140);
    const int iv = __builtin_bit_cast(int, v);
    const float a = __builtin_bit_cast(float, __builtin_amdgcn_readlane(iv, 0)), b = __builtin_bit_cast(float, __builtin_amdgcn_readlane(iv, 16));
    const float c = __builtin_bit_cast(float, __builtin_amdgcn_readlane(iv, 32)), d = __builtin_bit_cast(float, __builtin_amdgcn_readlane(iv, 48));
    return (a + b) + (c + d);
}
template <int NC> __device__ __forceinline__ float wave_colsum(const float (&part)[NC], LAS float* red, int lane) {
#pragma unroll
    for (int c = 0; c < NC; ++c) red[c * 64 + lane] = part[c];
    const int cc = lane < NC ? lane : NC - 1; float s = 0.f;
#pragma unroll
    for (int i = 0; i < 16; ++i) { const f32x4 v = *(const LAS f32x4*)(red + cc * 64 + i * 4); s += (v[0] + v[1]) + (v[2] + v[3]); }
    return s;
}
__device__ __forceinline__ float lane_bcast(float v, const int l) { return __builtin_bit_cast(float, __builtin_amdgcn_readlane(__builtin_bit_cast(int, v), l)); }
__device__ __forceinline__ void load_row_f32(f32x4 (&x)[4], const float* p, int lane) {
#pragma unroll
    for (int j = 0; j < 4; ++j) x[j] = *(const f32x4*)(p + 256 * j + 4 * lane);
}
__device__ __forceinline__ void load_row_bf16(f32x4 (&x)[4], const bf16* p, int lane) {
#pragma unroll
    for (int j = 0; j < 4; ++j) { const u32x2 w = *(const u32x2*)(p + 256 * j + 4 * lane); x[j] = (f32x4){bf_lo(w.x), bf_hi(w.x), bf_lo(w.y), bf_hi(w.y)}; }
}
__device__ __forceinline__ void store_row_bf16(bf16* p, const f32x4 (&x)[4], int lane) {
#pragma unroll
    for (int j = 0; j < 4; ++j) { u32x2 w; w.x = pg8::cvt_pk_bf16(x[j][0], x[j][1]); w.y = pg8::cvt_pk_bf16(x[j][2], x[j][3]); *(u32x2*)(p + 256 * j + 4 * lane) = w; }
}
__device__ __forceinline__ void modulate_gates(Frame& F, const f32x4 (&xo)[4], int m, int lg, const LAS float* wgT, LAS float* red) {
    const float* mod = (const float*)(F.ws + WS_MOD) + ((size_t)lg * 16 + (m >> 11)) * 6144;
    f32x4 u[4];
#pragma unroll
    for (int j = 0; j < 4; ++j) { const int col = 256 * j + 4 * F.lane; const f32x4 sh = *(const f32x4*)(mod + col), sc = *(const f32x4*)(mod + 1024 + col); u[j] = xo[j] * (1.0f + sc) + sh; }
    store_row_bf16((bf16*)(F.ws + WS_UA) + (size_t)m * D, u, F.lane);
    float g[8];
#pragma unroll
    for (int c = 0; c < 8; ++c) { float sacc = 0.f;
#pragma unroll
        for (int j = 0; j < 4; ++j) { const f32x4 w = *(const LAS f32x4*)(wgT + c * 1024 + 256 * j + 4 * F.lane); sacc += (u[j][0] * w[0] + u[j][1] * w[1]) + (u[j][2] * w[2] + u[j][3] * w[3]); }
        g[c] = sacc; }
    const float val = wave_colsum<8>(g, red, F.lane);
    if (F.lane < 8) ((float*)(F.ws + WS_GATES))[(size_t)m * 8 + F.lane] = val + F.in(I_BG)[lg * 8 + F.lane];
}
__device__ __forceinline__ void ln_row(f32x4 (&z)[4], gin g, gin b, int lane) {
    float sacc = 0.f;
#pragma unroll
    for (int j = 0; j < 4; ++j) sacc += (z[j][0] + z[j][1]) + (z[j][2] + z[j][3]);
    const float mean = wave_sum_dpp(sacc) * (1.0f / D); float q = 0.f;
#pragma unroll
    for (int j = 0; j < 4; ++j) { z[j] = z[j] - mean; q += (z[j][0] * z[j][0] + z[j][1] * z[j][1]) + (z[j][2] * z[j][2] + z[j][3] * z[j][3]); }
    const float rstd = 1.0f / sqrtf(wave_sum_dpp(q) * (1.0f / D) + LN_EPS);
#pragma unroll
    for (int j = 0; j < 4; ++j) { const int col = 256 * j + 4 * lane; const f32x4 gg = *(const GAS f32x4*)(g + col), bb = *(const GAS f32x4*)(b + col); z[j] = z[j] * rstd * gg + bb; }
}
__device__ __forceinline__ void phase_rowA(Frame& F) {
    rebind(F);
    LAS float* wgT = (LAS float*)F.lds; LAS float* red = (LAS float*)(F.lds + 32768 + F.wave * 5120);
    stage_cols_T(wgT, F.in(I_WIN), DIN_SRC, 2048, 8, F.tid);
    __syncthreads();
    const int gw = F.bid * NWAVES + F.wave, NGW = F.G * NWAVES;
    for (int m = gw; m < T; m += NGW) {
        f32x4 x[4];
#pragma unroll
        for (int j = 0; j < 4; ++j) x[j] = *(const GAS f32x4*)(F.in(I_X) + (size_t)m * D + 256 * j + 4 * F.lane);
        modulate_gates(F, x, m, 0, wgT, red);
    }
}
__device__ __forceinline__ void phase_rowB(Frame& F, int l) {
    rebind(F);
    LAS float* wrT = (LAS float*)F.lds;
    LAS float* red = (LAS float*)(F.lds + 81920 + F.wave * 5120);
    LAS int* lcnt = (LAS int*)(F.lds + MISC_OFF + MO_LCNT);
    LAS int* lbase = (LAS int*)(F.lds + MISC_OFF + MO_LBASE);
    LAS int* rec = (LAS int*)(F.lds + MISC_OFF + MO_REC);
    stage_cols_T(wrT, F.in(I_WGRP) + (size_t)l * D * 4, 4, 0, 4, F.tid);
    stage_cols_T(wrT + 4 * 1024, F.in(I_WR) + (size_t)l * D * 16, 16, 0, 16, F.tid);
    if (F.tid < NCLS) lcnt[F.tid] = 0;
    __syncthreads();
    const bf16* xprev = (const bf16*)F.out;
    const bf16* mix = (const bf16*)(F.ws + WS_BIG);
    bf16* x1p = (bf16*)(F.ws + WS_X1);
    RInfo* ri = (RInfo*)(F.ws + WS_RINFO);
    for (int rb = F.bid; rb < T / 128; rb += F.G) {
        for (int rl = F.wave; rl < 128; rl += NWAVES) {
            const int m = rb * 128 + rl;
            const float* mod = (const float*)(F.ws + WS_MOD) + ((size_t)l * 16 + (m >> 11)) * 6144;
            f32x4 z[4], mv[4];
            if (l == 0) {
#pragma unroll
                for (int j = 0; j < 4; ++j) z[j] = *(const GAS f32x4*)(F.in(I_X) + (size_t)m * D + 256 * j + 4 * F.lane);
            } else load_row_bf16(z, xprev + (size_t)m * D, F.lane);
            load_row_bf16(mv, mix + (size_t)m * D, F.lane);
#pragma unroll
            for (int j = 0; j < 4; ++j) { const f32x4 gt = *(const f32x4*)(mod + 2048 + 256 * j + 4 * F.lane); z[j] = z[j] * ALPHA + (1.0f + gt) * mv[j]; }
            ln_row(z, F.in(I_LN1G) + l * D, F.in(I_LN1B) + l * D, F.lane);
            store_row_bf16(x1p + (size_t)m * D, z, F.lane);
            f32x4 u[4];
#pragma unroll
            for (int j = 0; j < 4; ++j) { const int col = 256 * j + 4 * F.lane; const f32x4 sh = *(const f32x4*)(mod + 3072 + col), sc = *(const f32x4*)(mod + 4096 + col); u[j] = z[j] * (1.0f + sc) + sh; }
            store_row_bf16((bf16*)(F.ws + WS_UA) + (size_t)m * D, u, F.lane);
            float part[20];
#pragma unroll
            for (int c = 0; c < 20; ++c) { float sacc = 0.f;
#pragma unroll
                for (int j = 0; j < 4; ++j) { const f32x4 w = *(const LAS f32x4*)(wrT + c * 1024 + 256 * j + 4 * F.lane); sacc += (u[j][0] * w[0] + u[j][1] * w[1]) + (u[j][2] * w[2] + u[j][3] * w[3]); }
                part[c] = sacc; }
            const float tot = wave_colsum<20>(part, red, F.lane);
            float lg[20];
#pragma unroll
            for (int c = 0; c < 20; ++c) lg[c] = lane_bcast(tot, c);
            float gl[4];
#pragma unroll
            for (int j = 0; j < 4; ++j) gl[j] = lg[j] + F.in(I_BGRP)[l * 4 + j];
            int gi = 0; float gm = gl[0];
#pragma unroll
            for (int j = 1; j < 4; ++j) if (gl[j] > gm) { gm = gl[j]; gi = j; }
            float den = 0.f;
#pragma unroll
            for (int j = 0; j < 4; ++j) den += __expf(gl[j] - gm);
            const float grp_w = 1.0f / den;
            float el[4];
#pragma unroll
            for (int e = 0; e < 4; ++e) { float v = lg[4 + e];
#pragma unroll
                for (int g2 = 1; g2 < 4; ++g2) v = (gi == g2) ? lg[4 + g2 * 4 + e] : v;
                el[e] = v + F.in(I_BR)[l * 16 + gi * 4 + e]; }
            int i1 = 0; float v1 = el[0];
#pragma unroll
            for (int e = 1; e < 4; ++e) if (el[e] > v1) { v1 = el[e]; i1 = e; }
            int i2 = -1; float v2 = -3.0e38f;
#pragma unroll
            for (int e = 0; e < 4; ++e) if (e != i1 && el[e] > v2) { v2 = el[e]; i2 = e; }
            const float ex = __expf(v2 - v1), w1 = grp_w / (1.0f + ex), w2 = grp_w * ex / (1.0f + ex);
            const int ea = i1 < i2 ? i1 : i2, eb = i1 < i2 ? i2 : i1; const float wa = i1 < i2 ? w1 : w2, wb = i1 < i2 ? w2 : w1;
            const int p = ea == 0 ? eb - 1 : (ea == 1 ? eb + 1 : 5), cls = gi * 6 + p;
            if (F.lane == 0) { const int lr = __hip_atomic_fetch_add(lcnt + cls, 1, __ATOMIC_RELAXED, __HIP_MEMORY_SCOPE_WORKGROUP);
                rec[rl * 4 + 0] = cls; rec[rl * 4 + 1] = lr; rec[rl * 4 + 2] = __builtin_bit_cast(int, wa); rec[rl * 4 + 3] = __builtin_bit_cast(int, wb); }
        }
        __syncthreads();
        if (F.tid < NCLS) { const int n = lcnt[F.tid]; lbase[F.tid] = n ? (int)__hip_atomic_fetch_add(F.ctl + CW_CNT + l * 32 + F.tid, (unsigned)n, RLX_AGENT) : 0; }
        __syncthreads();
        if (F.tid < 128) { const int cls = rec[F.tid * 4], pos = lbase[cls] + rec[F.tid * 4 + 1];
            RInfo r; r.token = rb * 128 + F.tid; r.wa = __builtin_bit_cast(float, rec[F.tid * 4 + 2]); r.wb = __builtin_bit_cast(float, rec[F.tid * 4 + 3]); r.pad = 0;
            ri[(size_t)cls * CLS_CAP + pos] = r; }
        __syncthreads();
        if (F.tid < NCLS) lcnt[F.tid] = 0;
        __syncthreads();
    }
}
__device__ __forceinline__ void phase_rowC(Frame& F, int l) {
    rebind(F);
    LAS float* wgT = (LAS float*)F.lds; LAS float* red = (LAS float*)(F.lds + 32768 + F.wave * 5120);
    if (l + 1 < NL) stage_cols_T(wgT, F.in(I_WIN) + (size_t)(l + 1) * D * DIN_SRC, DIN_SRC, 2048, 8, F.tid);
    __syncthreads();
    const bf16* x1p = (const bf16*)(F.ws + WS_X1); const bf16* yp = (const bf16*)(F.ws + WS_Y);
    const int gw = F.bid * NWAVES + F.wave, NGW = F.G * NWAVES;
    for (int m = gw; m < T; m += NGW) {
        const float* mod = (const float*)(F.ws + WS_MOD) + ((size_t)l * 16 + (m >> 11)) * 6144;
        f32x4 z[4], yv[4];
        load_row_bf16(z, x1p + (size_t)m * D, F.lane); load_row_bf16(yv, yp + (size_t)m * D, F.lane);
#pragma unroll
        for (int j = 0; j < 4; ++j) { const f32x4 gt = *(const f32x4*)(mod + 5120 + 256 * j + 4 * F.lane); z[j] = z[j] * ALPHA + (1.0f + gt) * yv[j]; }
        ln_row(z, F.in(I_LN2G) + l * D, F.in(I_LN2B) + l * D, F.lane);
        if (l + 1 < NL) { store_row_bf16((bf16*)F.out + (size_t)m * D, z, F.lane); modulate_gates(F, z, m, l + 1, wgT, red); }
        else {
#pragma unroll
            for (int j = 0; j < 4; ++j) *(f32x4*)(F.out + (size_t)m * D + 256 * j + 4 * F.lane) = z[j]; }
    }
}

__device__ __forceinline__ void mlstm_naive_unit(Frame& F, int l, int bh) {
    const int b = bh >> 2, h = bh & 3, tid = F.tid, v = tid >> 2, kp = tid & 3;
    LAS float* Qs = (LAS float*)F.lds; LAS float* Ks = Qs + 64 * 128; LAS float* Vs = Ks + 64 * 128; LAS float* Hb = Vs + 64 * 128;
    LAS float* sg = (LAS float*)(F.lds + MISC_OFF + MO_SG);
    const bf16* proj = (const bf16*)(F.ws + WS_BIG); const float* gates = (const float*)(F.ws + WS_GATES);
    bf16* outp = (bf16*)(F.ws + WS_UA);
    float C[32], nn[32];
#pragma unroll
    for (int j = 0; j < 32; ++j) { C[j] = 0.f; nn[j] = 0.f; }
    float mst = 0.f;
    for (int blk = 0; blk < SEQ / 64; ++blk) {
        const int tok0 = b * SEQ + blk * 64;
#pragma unroll
        for (int i = 0; i < 2; ++i) { const int idx = tid + i * NTHR, row = idx >> 4, c8 = idx & 15; const bf16* p = proj + (size_t)(tok0 + row) * DINW + h * 128 + c8 * 8;
            const u32x4 q = *(const u32x4*)p, k = *(const u32x4*)(p + 512), vv = *(const u32x4*)(p + 1024);
            LAS float* dq = Qs + row * 128 + c8 * 8; LAS float* dk = Ks + row * 128 + c8 * 8; LAS float* dv = Vs + row * 128 + c8 * 8;
#pragma unroll
            for (int e = 0; e < 4; ++e) { dq[2 * e] = bf_lo(q[e]); dq[2 * e + 1] = bf_hi(q[e]); dk[2 * e] = bf_lo(k[e]); dk[2 * e + 1] = bf_hi(k[e]); dv[2 * e] = bf_lo(vv[e]); dv[2 * e + 1] = bf_hi(vv[e]); } }
        if (tid < 64) { const float ip = gates[(size_t)(tok0 + tid) * 8 + h], fp = gates[(size_t)(tok0 + tid) * 8 + 4 + h];
            const float lf = fminf(fp, 0.f) - log1pf(__expf(-fabsf(fp)));
            sg[tid * 2] = lf; sg[tid * 2 + 1] = ip; }
        __syncthreads();
        for (int t = 0; t < 64; ++t) {
            const float lf = sg[t * 2], ig = sg[t * 2 + 1];
            const float mnew = fmaxf(lf + mst, ig), fd = __expf(lf + mst - mnew), ii = __expf(ig - mnew); mst = mnew;
            const float vv = Vs[t * 128 + v] * ii;
            float hp = 0.f, dp = 0.f;
#pragma unroll
            for (int j4 = 0; j4 < 8; ++j4) { const f32x4 kk = *(const LAS f32x4*)(Ks + t * 128 + kp * 32 + j4 * 4), qq = *(const LAS f32x4*)(Qs + t * 128 + kp * 32 + j4 * 4);
#pragma unroll
                for (int e = 0; e < 4; ++e) { const int j = j4 * 4 + e; C[j] = fd * C[j] + vv * kk[e]; nn[j] = fd * nn[j] + ii * kk[e]; hp += C[j] * qq[e]; dp += nn[j] * qq[e]; } }
            hp += __shfl_xor(hp, 1); hp += __shfl_xor(hp, 2); dp += __shfl_xor(dp, 1); dp += __shfl_xor(dp, 2);
            const float hv = hp / fmaxf(fabsf(dp), __expf(-mst));
            if (kp == 0) Hb[t * 128 + v] = hv;
        }
        __syncthreads();
        { const int t = tid >> 3, part = tid & 7; float x[16]; float s = 0.f;
#pragma unroll
          for (int j = 0; j < 16; ++j) { x[j] = Hb[t * 128 + part * 16 + j]; s += x[j]; }
          s += __shfl_xor(s, 1); s += __shfl_xor(s, 2); s += __shfl_xor(s, 4);
          const float mean = s * (1.0f / 128.0f); float q = 0.f;
#pragma unroll
          for (int j = 0; j < 16; ++j) { x[j] -= mean; q += x[j] * x[j]; }
          q += __shfl_xor(q, 1); q += __shfl_xor(q, 2); q += __shfl_xor(q, 4);
          const float rstd = 1.0f / sqrtf(q * (1.0f / 128.0f) + LN_EPS);
          const bf16* op = proj + (size_t)(tok0 + t) * DINW + 1536 + h * 128 + part * 16; gin wn = F.in(I_MHW) + l * 512 + h * 128 + part * 16;
          const u32x4 o0 = *(const u32x4*)op, o1 = *(const u32x4*)(op + 8);
          float r[16];
#pragma unroll
          for (int e = 0; e < 4; ++e) { r[2 * e] = bf_lo(o0[e]); r[2 * e + 1] = bf_hi(o0[e]); r[8 + 2 * e] = bf_lo(o1[e]); r[8 + 2 * e + 1] = bf_hi(o1[e]); }
#pragma unroll
          for (int j = 0; j < 16; ++j) r[j] = x[j] * rstd * wn[j] * sigmoidf_(r[j]);
          u32x4 w0, w1;
#pragma unroll
          for (int e = 0; e < 4; ++e) { w0[e] = pk2(r[2 * e], r[2 * e + 1]); w1[e] = pk2(r[8 + 2 * e], r[8 + 2 * e + 1]); }
          bf16* dp2 = outp + (size_t)(tok0 + t) * D + h * 128 + part * 16; *(u32x4*)dp2 = w0; *(u32x4*)(dp2 + 8) = w1; }
        __syncthreads();
    }
}

#define LBAR() do { asm volatile("s_waitcnt lgkmcnt(0)" ::: "memory"); __builtin_amdgcn_s_barrier(); asm volatile("" ::: "memory"); } while (0)
__device__ __forceinline__ void mlstm_chunk_unit(Frame& F, int l, int bh) {
    const int b = bh >> 2, h = bh & 3, tid = F.tid, lane = F.lane, w = F.wave, fr = lane & 15, fq = lane >> 4;
    LAS unsigned char* L = F.lds;
    constexpr int QS = 0, KS = 17408, KW = 34816, VS = 53248, PS = 71680, CB = 80896, SC = 115712, NV = 119808, HS = 0;
    constexpr int QST = 272, WST = 288, TST = 144, HST = 132;
    typedef short v4i16_t __attribute__((ext_vector_type(4)));
#define TRFRAG(base, c, ks) __builtin_shufflevector( \
        __builtin_amdgcn_ds_read_tr16_b64_v4i16((LAS v4i16_t*)(L + (base) + (32 * (ks) + 8 * fq + ((lane & 15) >> 2)) * WST + (16 * (c) + 4 * (lane & 3)) * 2)), \
        __builtin_amdgcn_ds_read_tr16_b64_v4i16((LAS v4i16_t*)(L + (base) + (32 * (ks) + 8 * fq + 4 + ((lane & 15) >> 2)) * WST + (16 * (c) + 4 * (lane & 3)) * 2)), 0, 1, 2, 3, 4, 5, 6, 7)
    const bf16* proj = (const bf16*)(F.ws + WS_BIG); const float* gates = (const float*)(F.ws + WS_GATES); bf16* outp = (bf16*)(F.ws + WS_UA);
    const int tokb = b * SEQ;
    for (int i = lane; i < 16 * QST / 16; i += 64) *(LAS u32x4*)(L + CB + w * 16 * QST + i * 16) = (u32x4){0u, 0u, 0u, 0u};
    if (tid < 128) ((LAS float*)(L + NV))[tid] = 0.f;
    f32x4 acc2[8];
#pragma unroll
    for (int kt = 0; kt < 8; ++kt) acc2[kt] = (f32x4){0.f, 0.f, 0.f, 0.f};
    f32x4 nacc = (f32x4){0.f, 0.f, 0.f, 0.f};
    const bf16x8 ones = (bf16x8){0x3F80, 0x3F80, 0x3F80, 0x3F80, 0x3F80, 0x3F80, 0x3F80, 0x3F80};
    float m_st = 0.f;
    float g_ip = gates[(size_t)(tokb + lane) * 8 + h], g_fp = gates[(size_t)(tokb + lane) * 8 + 4 + h];
#define MLSTM_SCALARS(sbn) do { \
        const float lf_ = fminf(g_fp, 0.f) - log1pf(__expf(-fabsf(g_fp))); float bc_ = lf_; \
        _Pragma("unroll") for (int d_ = 1; d_ < 64; d_ <<= 1) { const float v_ = __shfl_up(bc_, d_); if (lane >= d_) bc_ += v_; } \
        const float r_ = g_ip - bc_; float pm_ = r_; \
        _Pragma("unroll") for (int d_ = 1; d_ < 64; d_ <<= 1) { const float v_ = __shfl_up(pm_, d_); if (lane >= d_) pm_ = fmaxf(pm_, v_); } \
        const float gtot_ = __shfl(bc_, 63), pm63_ = __shfl(pm_, 63); \
        const float M_ = fmaxf(m_st, pm_), Mx_ = fmaxf(m_st, pm63_); \
        (sbn)[lane] = r_; (sbn)[64 + lane] = M_; (sbn)[128 + lane] = __expf(m_st - M_); (sbn)[192 + lane] = __expf(-(bc_ + M_)); (sbn)[256 + lane] = __expf(r_ - Mx_); \
        if (lane == 0) (sbn)[320] = __expf(m_st - Mx_); \
        m_st = gtot_ + Mx_; } while (0)
    if (w == 0) MLSTM_SCALARS((LAS float*)(L + SC));
    const int prow = 8 * w + (lane >> 4), pch = lane & 15;
    u32x4 rq[2], rk[2], rv[2], ro[2], ro2[2];
#pragma unroll
    for (int i = 0; i < 2; ++i) { const bf16* p = proj + (size_t)(tokb + prow + 4 * i) * DINW + h * 128 + pch * 8; rq[i] = *(const u32x4*)p; rk[i] = *(const u32x4*)(p + 512); rv[i] = *(const u32x4*)(p + 1024); }
    { const bf16* p = proj + (size_t)(tokb + (tid >> 3)) * DINW + 1536 + h * 128 + (tid & 7) * 16; ro[0] = *(const u32x4*)p; ro[1] = *(const u32x4*)(p + 8); }
    ro2[0] = ro[0]; ro2[1] = ro[1];
    __syncthreads();
    for (int c = 0; c < SEQ / 64; ++c) {
        const LAS float* sb = (const LAS float*)(L + SC + (c & 1) * 2048);
        LAS float* sbn = (LAS float*)(L + SC + ((c + 1) & 1) * 2048);
        const int tok0 = tokb + c * 64;
        const bool more = (c + 1) < SEQ / 64;
#pragma unroll
        for (int i = 0; i < 2; ++i) { const int row = prow + 4 * i; const float wu = sb[256 + row];
            *(LAS u32x4*)(L + QS + row * QST + pch * 16) = rq[i]; *(LAS u32x4*)(L + KS + row * QST + pch * 16) = rk[i]; *(LAS u32x4*)(L + VS + row * WST + pch * 16) = rv[i];
            u32x4 kw;
#pragma unroll
            for (int e = 0; e < 4; ++e) kw[e] = pk2(bf_lo(rk[i][e]) * wu, bf_hi(rk[i][e]) * wu);
            *(LAS u32x4*)(L + KW + row * WST + pch * 16) = kw; }
        const int tokn = more ? tok0 + 64 : tok0;
        g_ip = gates[(size_t)(tokn + lane) * 8 + h]; g_fp = gates[(size_t)(tokn + lane) * 8 + 4 + h];
        LBAR();
#pragma unroll
        for (int i = 0; i < 2; ++i) { const bf16* p = proj + (size_t)(tokn + prow + 4 * i) * DINW + h * 128 + pch * 8; rq[i] = *(const u32x4*)p; rk[i] = *(const u32x4*)(p + 512); rv[i] = *(const u32x4*)(p + 1024); }
        { const bf16* p = proj + (size_t)(tokn + (tid >> 3)) * DINW + 1536 + h * 128 + (tid & 7) * 16; ro2[0] = *(const u32x4*)p; ro2[1] = *(const u32x4*)(p + 8); }
        { const int tt = w >> 1;
#pragma unroll
          for (int j = 0; j < 2; ++j) { const int ts = 2 * (w & 1) + j; f32x4 sa = (f32x4){0.f, 0.f, 0.f, 0.f};
            if (ts <= tt) {
#pragma unroll
                for (int ks = 0; ks < 4; ++ks) { const bf16x8 a = *(const LAS bf16x8*)(L + QS + (tt * 16 + fr) * QST + ks * 64 + fq * 16), bb = *(const LAS bf16x8*)(L + KS + (ts * 16 + fr) * QST + ks * 64 + fq * 16);
                    sa = __builtin_amdgcn_mfma_f32_16x16x32_bf16(a, bb, sa, 0, 0, 0); } }
            const int si = ts * 16 + fr; const float rs = sb[si];
#pragma unroll
            for (int rg = 0; rg < 4; ++rg) { const int ti = tt * 16 + 4 * fq + rg; const float pw = sa[rg] * __expf(rs - sb[64 + ti]);
                *(LAS unsigned short*)(L + PS + ti * TST + si * 2) = (unsigned short)f2bf(si <= ti ? pw : 0.f); } } }
        LBAR();
        { const int t = tid >> 3, part = tid & 7; const u32x4 pp = *(const LAS u32x4*)(L + PS + t * TST + part * 16); float d1 = 0.f, d2 = 0.f;
#pragma unroll
          for (int e = 0; e < 4; ++e) d1 += bf_lo(pp[e]) + bf_hi(pp[e]);
#pragma unroll
          for (int i = 0; i < 2; ++i) { const u32x4 qq = *(const LAS u32x4*)(L + QS + t * QST + part * 32 + i * 16);
#pragma unroll
            for (int e = 0; e < 4; ++e) { const f32x2 nv = *(const LAS f32x2*)(L + NV + (part * 16 + i * 8 + 2 * e) * 4); d2 += bf_lo(qq[e]) * nv[0] + bf_hi(qq[e]) * nv[1]; } }
          d1 += __shfl_xor(d1, 1); d1 += __shfl_xor(d1, 2); d1 += __shfl_xor(d1, 4); d2 += __shfl_xor(d2, 1); d2 += __shfl_xor(d2, 2); d2 += __shfl_xor(d2, 4);
          const float den = d1 + sb[128 + t] * d2;
          if (part == 0) ((LAS float*)(L + SC + (c & 1) * 2048))[384 + t] = 1.0f / fmaxf(fabsf(den), sb[192 + t]); }
        f32x4 n1[4], nI[4]; bf16x8 vf[2];
#pragma unroll
        for (int ks = 0; ks < 2; ++ks) vf[ks] = TRFRAG(VS, w, ks);
#pragma unroll
        for (int t4 = 0; t4 < 4; ++t4) { n1[t4] = (f32x4){0.f, 0.f, 0.f, 0.f}; nI[t4] = (f32x4){0.f, 0.f, 0.f, 0.f};
#pragma unroll
            for (int ks = 0; ks < 2; ++ks) if (ks * 32 <= t4 * 16 + 15) { const bf16x8 a = *(const LAS bf16x8*)(L + PS + (t4 * 16 + fr) * TST + ks * 64 + fq * 16); n1[t4] = __builtin_amdgcn_mfma_f32_16x16x32_bf16(a, vf[ks], n1[t4], 0, 0, 0); } }
        { bf16x8 cf[4];
#pragma unroll
          for (int ks = 0; ks < 4; ++ks) cf[ks] = *(const LAS bf16x8*)(L + CB + (w * 16 + fr) * QST + ks * 64 + fq * 16);
#pragma unroll
          for (int t4 = 0; t4 < 4; ++t4)
#pragma unroll
            for (int ks = 0; ks < 4; ++ks) { const bf16x8 a = *(const LAS bf16x8*)(L + QS + (t4 * 16 + fr) * QST + ks * 64 + fq * 16); nI[t4] = __builtin_amdgcn_mfma_f32_16x16x32_bf16(a, cf[ks], nI[t4], 0, 0, 0); } }
        LBAR();
#pragma unroll
        for (int t4 = 0; t4 < 4; ++t4)
#pragma unroll
            for (int rg = 0; rg < 4; ++rg) { const int ti = t4 * 16 + 4 * fq + rg; ((LAS float*)(L + HS))[ti * HST + w * 16 + fr] = n1[t4][rg] + sb[128 + ti] * nI[t4][rg]; }
        { const float dec = sb[320];
#pragma unroll
          for (int kt = 0; kt < 8; ++kt) { acc2[kt] = acc2[kt] * dec;
            if (kt == w) nacc = nacc * dec;
#pragma unroll
            for (int ks = 0; ks < 2; ++ks) { const bf16x8 a = TRFRAG(KW, kt, ks); acc2[kt] = __builtin_amdgcn_mfma_f32_16x16x32_bf16(a, vf[ks], acc2[kt], 0, 0, 0);
                if (kt == w) nacc = __builtin_amdgcn_mfma_f32_16x16x32_bf16(a, ones, nacc, 0, 0, 0); }
            u32x2 wv; wv.x = pk2(acc2[kt][0], acc2[kt][1]); wv.y = pk2(acc2[kt][2], acc2[kt][3]);
            *(LAS u32x2*)(L + CB + (w * 16 + fr) * QST + (kt * 16 + 4 * fq) * 2) = wv; }
          if (fr == 0) *(LAS f32x4*)(L + NV + (w * 16 + 4 * fq) * 4) = nacc; }
        if (w == 0 && more) MLSTM_SCALARS(sbn);
        LBAR();
        { const int t = tid >> 3, part = tid & 7; const float dinv = sb[384 + t]; float x[16]; float sm = 0.f;
#pragma unroll
          for (int i = 0; i < 4; ++i) { const f32x4 hv = *(const LAS f32x4*)(L + HS + (t * HST + part * 16 + i * 4) * 4);
#pragma unroll
            for (int e = 0; e < 4; ++e) { x[i * 4 + e] = hv[e] * dinv; sm += x[i * 4 + e]; } }
          sm += __shfl_xor(sm, 1); sm += __shfl_xor(sm, 2); sm += __shfl_xor(sm, 4);
          const float mean = sm * (1.0f / 128.0f); float qv = 0.f;
#pragma unroll
          for (int j = 0; j < 16; ++j) { x[j] -= mean; qv += x[j] * x[j]; }
          qv += __shfl_xor(qv, 1); qv += __shfl_xor(qv, 2); qv += __shfl_xor(qv, 4);
          const float rstd = 1.0f / sqrtf(qv * (1.0f / 128.0f) + LN_EPS);
          gin wn = F.in(I_MHW) + l * 512 + h * 128 + part * 16;
          float rr[16];
#pragma unroll
          for (int e = 0; e < 4; ++e) { rr[2 * e] = bf_lo(ro[0][e]); rr[2 * e + 1] = bf_hi(ro[0][e]); rr[8 + 2 * e] = bf_lo(ro[1][e]); rr[8 + 2 * e + 1] = bf_hi(ro[1][e]); }
#pragma unroll
          for (int j = 0; j < 16; ++j) rr[j] = x[j] * rstd * wn[j] * sigmoidf_(rr[j]);
          u32x4 w0, w1;
#pragma unroll
          for (int e = 0; e < 4; ++e) { w0[e] = pk2(rr[2 * e], rr[2 * e + 1]); w1[e] = pk2(rr[8 + 2 * e], rr[8 + 2 * e + 1]); }
          bf16* dp2 = outp + (size_t)(tok0 + t) * D + h * 128 + part * 16; *(u32x4*)dp2 = w0; *(u32x4*)(dp2 + 8) = w1; }
        ro[0] = ro2[0]; ro[1] = ro2[1];
        LBAR();
    }
#undef MLSTM_SCALARS
#undef TRFRAG
}

#define TRFRAG2(base, stride, c, ks) __builtin_shufflevector( \
        __builtin_amdgcn_ds_read_tr16_b64_v4i16((LAS v4i16_t*)(L + (base) + (32 * (ks) + 8 * fq + ((lane & 15) >> 2)) * (stride) + (16 * (c) + 4 * (lane & 3)) * 2)), \
        __builtin_amdgcn_ds_read_tr16_b64_v4i16((LAS v4i16_t*)(L + (base) + (32 * (ks) + 8 * fq + 4 + ((lane & 15) >> 2)) * (stride) + (16 * (c) + 4 * (lane & 3)) * 2)), 0, 1, 2, 3, 4, 5, 6, 7)
typedef short v4i16_t __attribute__((ext_vector_type(4)));
__device__ __forceinline__ void mlstm_state_unit(Frame& F, int l, int unit) {
    const int bh = unit >> 2, vq = unit & 3, b = bh >> 2, h = bh & 3, tid = F.tid, lane = F.lane, w = F.wave, fr = lane & 15, fq = lane >> 4;
    LAS unsigned char* L = F.lds;
    constexpr int KW = 0, VS = 18432, ST = 23552, BUF = 32256, WST = 288, VST = 80, SST = 272;
    const bf16* proj = (const bf16*)(F.ws + WS_BIG); const float* gates = (const float*)(F.ws + WS_GATES);
    bf16* cst = (bf16*)(F.ws + WS_CST); float* nprev = (float*)(F.ws + WS_NPREV); float* mstp = (float*)(F.ws + WS_MST);
    const int tokb = b * SEQ, prow = 8 * w + (lane >> 4), pch = lane & 15, vrow = (tid >> 2) & 63, vch = tid & 3;
    const bf16x8 ones = (bf16x8){0x3F80, 0x3F80, 0x3F80, 0x3F80, 0x3F80, 0x3F80, 0x3F80, 0x3F80};
    f32x4 acc[2] = {(f32x4){0.f, 0.f, 0.f, 0.f}, (f32x4){0.f, 0.f, 0.f, 0.f}}, nacc = (f32x4){0.f, 0.f, 0.f, 0.f};
    float m_st = 0.f;
    u32x4 rk[2], rv;
    float g_ip = gates[(size_t)(tokb + lane) * 8 + h], g_fp = gates[(size_t)(tokb + lane) * 8 + 4 + h];
#pragma unroll
    for (int i = 0; i < 2; ++i) rk[i] = *(const u32x4*)(proj + (size_t)(tokb + prow + 4 * i) * DINW + 512 + h * 128 + pch * 8);
    rv = *(const u32x4*)(proj + (size_t)(tokb + vrow) * DINW + 1024 + h * 128 + vq * 32 + vch * 8);
    for (int c = 0; c < SEQ / 64; ++c) {
        const int tok0 = tokb + c * 64, buf = (c & 1) * BUF;
        const float lf = fminf(g_fp, 0.f) - log1pf(__expf(-fabsf(g_fp))); float bc = lf;
#pragma unroll
        for (int d = 1; d < 64; d <<= 1) { const float v = __shfl_up(bc, d); if (lane >= d) bc += v; }
        const float r = g_ip - bc; float pm = r;
#pragma unroll
        for (int d = 1; d < 64; d <<= 1) { const float v = __shfl_up(pm, d); if (lane >= d) pm = fmaxf(pm, v); }
        const float gtot = __shfl(bc, 63), Mx = fmaxf(m_st, __shfl(pm, 63)), wul = __expf(r - Mx), dec = __expf(m_st - Mx);
        if (vq == 0) { if (tid == 0) mstp[bh * 32 + c] = m_st; if (fr == 0) *(f32x4*)(nprev + (size_t)(bh * 32 + c) * 128 + w * 16 + 4 * fq) = nacc; }
#pragma unroll
        for (int vt = 0; vt < 2; ++vt) { u32x2 wv; wv.x = pg8::cvt_pk_bf16(acc[vt][0], acc[vt][1]); wv.y = pg8::cvt_pk_bf16(acc[vt][2], acc[vt][3]);
            *(LAS u32x2*)(L + buf + ST + (vt * 16 + fr) * SST + (w * 16 + 4 * fq) * 2) = wv; }
#pragma unroll
        for (int i = 0; i < 2; ++i) { const int row = prow + 4 * i; const float wu = __shfl(wul, row); u32x4 kw;
#pragma unroll
            for (int e = 0; e < 4; ++e) kw[e] = pg8::cvt_pk_bf16(bf_lo(rk[i][e]) * wu, bf_hi(rk[i][e]) * wu);
            *(LAS u32x4*)(L + buf + KW + row * WST + pch * 16) = kw; }
        if (tid < 256) *(LAS u32x4*)(L + buf + VS + vrow * VST + vch * 16) = rv;
        const int tokn = (c + 1 < SEQ / 64) ? tok0 + 64 : tok0;
        g_ip = gates[(size_t)(tokn + lane) * 8 + h]; g_fp = gates[(size_t)(tokn + lane) * 8 + 4 + h];
#pragma unroll
        for (int i = 0; i < 2; ++i) rk[i] = *(const u32x4*)(proj + (size_t)(tokn + prow + 4 * i) * DINW + 512 + h * 128 + pch * 8);
        rv = *(const u32x4*)(proj + (size_t)(tokn + vrow) * DINW + 1024 + h * 128 + vq * 32 + vch * 8);
        LBAR();
        { const int row = tid >> 4, ch = tid & 15; const u32x4 x = *(const LAS u32x4*)(L + buf + ST + row * SST + ch * 16);
          *(u32x4*)(cst + ((size_t)(bh * 32 + c) * 128 + vq * 32 + row) * 128 + ch * 8) = x; }
        { bf16x8 af[2];
#pragma unroll
          for (int ks = 0; ks < 2; ++ks) af[ks] = TRFRAG2(buf + KW, WST, w, ks);
          nacc = nacc * dec;
#pragma unroll
          for (int ks = 0; ks < 2; ++ks) nacc = __builtin_amdgcn_mfma_f32_16x16x32_bf16(af[ks], ones, nacc, 0, 0, 0);
#pragma unroll
          for (int vt = 0; vt < 2; ++vt) { acc[vt] = acc[vt] * dec;
#pragma unroll
            for (int ks = 0; ks < 2; ++ks) { const bf16x8 bfr = TRFRAG2(buf + VS, VST, vt, ks); acc[vt] = __builtin_amdgcn_mfma_f32_16x16x32_bf16(af[ks], bfr, acc[vt], 0, 0, 0); } } }
        m_st = gtot + Mx;
    }
    LBAR();
}

__device__ __forceinline__ void mlstm_out_phase(Frame& F, int l) {
    const int tid = F.tid, lane = F.lane, w = F.wave, fr = lane & 15, fq = lane >> 4;
    LAS unsigned char* L = F.lds;
    constexpr int QS = 0, KS = 17408, VS = 34816, PS = 53248, CB = 62464, SC = 97280, NV = 99328, HS = 0;
    constexpr int QST = 272, WST = 288, TST = 144, HST = 132;
    constexpr int NCH = 64 * (SEQ / 64);
    const bf16* proj = (const bf16*)(F.ws + WS_BIG); const float* gates = (const float*)(F.ws + WS_GATES); bf16* outp = (bf16*)(F.ws + WS_UA);
    const bf16* cst = (const bf16*)(F.ws + WS_CST); const float* nprev = (const float*)(F.ws + WS_NPREV); const float* mstp = (const float*)(F.ws + WS_MST);
    const int prow = 8 * w + (lane >> 4), pch = lane & 15;
    int cid = F.bid; if (cid >= NCH) return;
    u32x4 rq[2], rk[2], rv[2], ro[2], ro2[2], rc[4]; f32x4 rn = (f32x4){0.f, 0.f, 0.f, 0.f}; float g_ip, g_fp, g_m;
#define MLO_FETCH(CID, RO) do { const int bh_ = (CID) >> 5, c_ = (CID) & 31, h_ = bh_ & 3, tk_ = (bh_ >> 2) * SEQ + c_ * 64; \
        _Pragma("unroll") for (int i = 0; i < 2; ++i) { const bf16* p = proj + (size_t)(tk_ + prow + 4 * i) * DINW + h_ * 128 + pch * 8; rq[i] = *(const u32x4*)p; rk[i] = *(const u32x4*)(p + 512); rv[i] = *(const u32x4*)(p + 1024); } \
        { const bf16* p = proj + (size_t)(tk_ + (tid >> 3)) * DINW + 1536 + h_ * 128 + (tid & 7) * 16; RO[0] = *(const u32x4*)p; RO[1] = *(const u32x4*)(p + 8); } \
        { const bf16* p = cst + ((size_t)(CID) * 128 + (tid >> 2)) * 128 + (tid & 3) * 32; _Pragma("unroll") for (int j = 0; j < 4; ++j) rc[j] = *(const u32x4*)(p + j * 8); } \
        rn = *(const f32x4*)(nprev + (size_t)(CID) * 128 + (tid & 31) * 4); \
        g_ip = gates[(size_t)(tk_ + lane) * 8 + h_]; g_fp = gates[(size_t)(tk_ + lane) * 8 + 4 + h_]; g_m = __hip_atomic_load(mstp + (CID), RLX_AGENT); } while (0)
    MLO_FETCH(cid, ro);
    ro2[0] = ro[0]; ro2[1] = ro[1];
    for (;;) {
        const int bh = cid >> 5, c = cid & 31, h = bh & 3, tok0 = (bh >> 2) * SEQ + c * 64;
        const int nxt = cid + F.G; const bool more = nxt < NCH; const int cidn = more ? nxt : cid;
        LAS float* sb = (LAS float*)(L + SC);
#pragma unroll
        for (int i = 0; i < 2; ++i) { const int row = prow + 4 * i;
            *(LAS u32x4*)(L + QS + row * QST + pch * 16) = rq[i]; *(LAS u32x4*)(L + KS + row * QST + pch * 16) = rk[i]; *(LAS u32x4*)(L + VS + row * WST + pch * 16) = rv[i]; }
#pragma unroll
        for (int j = 0; j < 4; ++j) *(LAS u32x4*)(L + CB + (tid >> 2) * QST + (tid & 3) * 64 + j * 16) = rc[j];
        if (tid < 32) *(LAS f32x4*)(L + NV + tid * 16) = rn;
        if (w == 0) {
            const float m_st = g_m;
            const float lf = fminf(g_fp, 0.f) - log1pf(__expf(-fabsf(g_fp))); float bc = lf;
#pragma unroll
            for (int d = 1; d < 64; d <<= 1) { const float v = __shfl_up(bc, d); if (lane >= d) bc += v; }
            const float r = g_ip - bc; float pm = r;
#pragma unroll
            for (int d = 1; d < 64; d <<= 1) { const float v = __shfl_up(pm, d); if (lane >= d) pm = fmaxf(pm, v); }
            const float M = fmaxf(m_st, pm);
            sb[lane] = r; sb[64 + lane] = M; sb[128 + lane] = __expf(m_st - M); sb[192 + lane] = __expf(-(bc + M)); }
        LBAR();
        MLO_FETCH(cidn, ro2);
        { const int tt = w >> 1;
#pragma unroll
          for (int j = 0; j < 2; ++j) { const int ts = 2 * (w & 1) + j; f32x4 sa = (f32x4){0.f, 0.f, 0.f, 0.f};
            if (ts <= tt) {
#pragma unroll
                for (int ks = 0; ks < 4; ++ks) { const bf16x8 a = *(const LAS bf16x8*)(L + QS + (tt * 16 + fr) * QST + ks * 64 + fq * 16), bb = *(const LAS bf16x8*)(L + KS + (ts * 16 + fr) * QST + ks * 64 + fq * 16);
                    sa = __builtin_amdgcn_mfma_f32_16x16x32_bf16(a, bb, sa, 0, 0, 0); } }
            const int si = ts * 16 + fr; const float rs = sb[si];
#pragma unroll
            for (int rg = 0; rg < 4; ++rg) { const int ti = tt * 16 + 4 * fq + rg; const float pw = sa[rg] * __expf(rs - sb[64 + ti]);
                *(LAS unsigned short*)(L + PS + ti * TST + si * 2) = (unsigned short)f2bf(si <= ti ? pw : 0.f); } } }
        LBAR();
        { const int t = tid >> 3, part = tid & 7; const u32x4 pp = *(const LAS u32x4*)(L + PS + t * TST + part * 16); float d1 = 0.f, d2 = 0.f;
#pragma unroll
          for (int e = 0; e < 4; ++e) d1 += bf_lo(pp[e]) + bf_hi(pp[e]);
#pragma unroll
          for (int i = 0; i < 2; ++i) { const u32x4 qq = *(const LAS u32x4*)(L + QS + t * QST + part * 32 + i * 16);
#pragma unroll
            for (int e = 0; e < 4; ++e) { const f32x2 nv = *(const LAS f32x2*)(L + NV + (part * 16 + i * 8 + 2 * e) * 4); d2 += bf_lo(qq[e]) * nv[0] + bf_hi(qq[e]) * nv[1]; } }
          d1 += __shfl_xor(d1, 1); d1 += __shfl_xor(d1, 2); d1 += __shfl_xor(d1, 4); d2 += __shfl_xor(d2, 1); d2 += __shfl_xor(d2, 2); d2 += __shfl_xor(d2, 4);
          const float den = d1 + sb[128 + t] * d2;
          if (part == 0) sb[384 + t] = __builtin_amdgcn_rcpf(fmaxf(fabsf(den), sb[192 + t])); }
        f32x4 n1[4], nI[4]; bf16x8 vf[2];
#pragma unroll
        for (int ks = 0; ks < 2; ++ks) vf[ks] = TRFRAG2(VS, WST, w, ks);
#pragma unroll
        for (int t4 = 0; t4 < 4; ++t4) { n1[t4] = (f32x4){0.f, 0.f, 0.f, 0.f}; nI[t4] = (f32x4){0.f, 0.f, 0.f, 0.f};
#pragma unroll
            for (int ks = 0; ks < 2; ++ks) if (ks * 32 <= t4 * 16 + 15) { const bf16x8 a = *(const LAS bf16x8*)(L + PS + (t4 * 16 + fr) * TST + ks * 64 + fq * 16); n1[t4] = __builtin_amdgcn_mfma_f32_16x16x32_bf16(a, vf[ks], n1[t4], 0, 0, 0); } }
        { bf16x8 cf[4];
#pragma unroll
          for (int ks = 0; ks < 4; ++ks) cf[ks] = *(const LAS bf16x8*)(L + CB + (w * 16 + fr) * QST + ks * 64 + fq * 16);
#pragma unroll
          for (int t4 = 0; t4 < 4; ++t4)
#pragma unroll
            for (int ks = 0; ks < 4; ++ks) { const bf16x8 a = *(const LAS bf16x8*)(L + QS + (t4 * 16 + fr) * QST + ks * 64 + fq * 16); nI[t4] = __builtin_amdgcn_mfma_f32_16x16x32_bf16(a, cf[ks], nI[t4], 0, 0, 0); } }
        LBAR();
#pragma unroll
        for (int t4 = 0; t4 < 4; ++t4)
#pragma unroll
            for (int rg = 0; rg < 4; ++rg) { const int ti = t4 * 16 + 4 * fq + rg; ((LAS float*)(L + HS))[ti * HST + w * 16 + fr] = n1[t4][rg] + sb[128 + ti] * nI[t4][rg]; }
        LBAR();
        { const int t = tid >> 3, part = tid & 7; const float dinv = sb[384 + t]; float x[16]; float sm = 0.f;
#pragma unroll
          for (int i = 0; i < 4; ++i) { const f32x4 hv = *(const LAS f32x4*)(L + HS + (t * HST + part * 16 + i * 4) * 4);
#pragma unroll
            for (int e = 0; e < 4; ++e) { x[i * 4 + e] = hv[e] * dinv; sm += x[i * 4 + e]; } }
          sm += __shfl_xor(sm, 1); sm += __shfl_xor(sm, 2); sm += __shfl_xor(sm, 4);
          const float mean = sm * (1.0f / 128.0f); float qv = 0.f;
#pragma unroll
          for (int j = 0; j < 16; ++j) { x[j] -= mean; qv += x[j] * x[j]; }
          qv += __shfl_xor(qv, 1); qv += __shfl_xor(qv, 2); qv += __shfl_xor(qv, 4);
          const float rstd = __builtin_amdgcn_rsqf(qv * (1.0f / 128.0f) + LN_EPS);
          gin wn = F.in(I_MHW) + l * 512 + h * 128 + part * 16;
          float rr[16];
#pragma unroll
          for (int e = 0; e < 4; ++e) { rr[2 * e] = bf_lo(ro[0][e]); rr[2 * e + 1] = bf_hi(ro[0][e]); rr[8 + 2 * e] = bf_lo(ro[1][e]); rr[8 + 2 * e + 1] = bf_hi(ro[1][e]); }
#pragma unroll
          for (int j = 0; j < 16; ++j) rr[j] = x[j] * rstd * wn[j] * __builtin_amdgcn_rcpf(1.0f + __expf(-rr[j]));
          u32x4 w0, w1;
#pragma unroll
          for (int e = 0; e < 4; ++e) { w0[e] = pg8::cvt_pk_bf16(rr[2 * e], rr[2 * e + 1]); w1[e] = pg8::cvt_pk_bf16(rr[8 + 2 * e], rr[8 + 2 * e + 1]); }
          bf16* dp2 = outp + (size_t)(tok0 + t) * D + h * 128 + part * 16; *(u32x4*)dp2 = w0; *(u32x4*)(dp2 + 8) = w1; }
        ro[0] = ro2[0]; ro[1] = ro2[1];
        LBAR();
        if (!more) break;
        cid = nxt;
    }
#undef MLO_FETCH
}
__device__ __forceinline__ void conv_items(Frame& F, int l, int first_block, int nblocks) {
    const bf16* proj = (const bf16*)(F.ws + WS_BIG); bf16* outp = (bf16*)(F.ws + WS_UA);
    const int nthreads = nblocks * NTHR;
    for (int id = (F.bid - first_block) * NTHR + F.tid; id < (T / 32) * 64; id += nthreads) {
        const int cg = id & 63, run = id >> 6, t0 = run * 32, c0 = cg * 8;
        float w[3][8];
#pragma unroll
        for (int j = 0; j < 3; ++j)
#pragma unroll
            for (int e = 0; e < 8; ++e) w[j][e] = F.in(I_WCONV)[(size_t)l * 3 * 512 + j * 512 + c0 + e];
        float z1[8], z2[8];
#pragma unroll
        for (int e = 0; e < 8; ++e) { z1[e] = 0.f; z2[e] = 0.f; }
        if ((t0 & (SEQ - 1)) != 0) {
#pragma unroll
            for (int back = 1; back <= 2; ++back) { const bf16* p = proj + (size_t)(t0 - back) * DINW + 2560 + c0; const u32x4 cc = *(const u32x4*)p, ch = *(const u32x4*)(p + 512);
#pragma unroll
                for (int e = 0; e < 4; ++e) { const float a = bf_lo(cc[e]) * bf_lo(ch[e]), b2 = bf_hi(cc[e]) * bf_hi(ch[e]); if (back == 1) { z1[2 * e] = a; z1[2 * e + 1] = b2; } else { z2[2 * e] = a; z2[2 * e + 1] = b2; } } }
        }
        for (int t = t0; t < t0 + 32; ++t) { const bf16* p = proj + (size_t)t * DINW + 2048 + c0; const u32x4 cb = *(const u32x4*)p, cc = *(const u32x4*)(p + 512), ch = *(const u32x4*)(p + 1024);
            float z0[8], y[8];
#pragma unroll
            for (int e = 0; e < 4; ++e) { z0[2 * e] = bf_lo(cc[e]) * bf_lo(ch[e]); z0[2 * e + 1] = bf_hi(cc[e]) * bf_hi(ch[e]); }
#pragma unroll
            for (int e = 0; e < 4; ++e) { y[2 * e] = bf_lo(cb[e]) * (w[0][2 * e] * z2[2 * e] + w[1][2 * e] * z1[2 * e] + w[2][2 * e] * z0[2 * e]);
                y[2 * e + 1] = bf_hi(cb[e]) * (w[0][2 * e + 1] * z2[2 * e + 1] + w[1][2 * e + 1] * z1[2 * e + 1] + w[2][2 * e + 1] * z0[2 * e + 1]); }
            u32x4 o;
#pragma unroll
            for (int e = 0; e < 4; ++e) o[e] = pk2(y[2 * e], y[2 * e + 1]);
            *(u32x4*)(outp + (size_t)t * D + 512 + c0) = o;
#pragma unroll
            for (int e = 0; e < 8; ++e) { z2[e] = z1[e]; z1[e] = z0[e]; } }
    }
}
__device__ __forceinline__ void phase_mix1(Frame& F, int l) {
    rebind(F);
    for (int u = F.bid; u < 256; u += F.G) mlstm_state_unit(F, l, u);
    conv_items(F, l, 0, F.G);
}
__device__ __forceinline__ void phase_mix2(Frame& F, int l) { rebind(F); mlstm_out_phase(F, l); }
__device__ __forceinline__ void phase_mixer(Frame& F, int l) {
    rebind(F);
    const int nm = F.G > 64 ? 64 : 0;
#ifdef MIXER_NAIVE
    if (nm) { if (F.bid < 64) mlstm_naive_unit(F, l, F.bid); else conv_items(F, l, 64, F.G - 64); }
    else { for (int u = F.bid; u < 64; u += F.G) mlstm_naive_unit(F, l, u); conv_items(F, l, 0, F.G); }
#else
    if (nm) { if (F.bid < 64) mlstm_chunk_unit(F, l, F.bid); else conv_items(F, l, 64, F.G - 64); }
    else { for (int u = F.bid; u < 64; u += F.G) { mlstm_chunk_unit(F, l, u); __syncthreads(); } conv_items(F, l, 0, F.G); }
#endif
}

__device__ __forceinline__ int moe_tables(Frame& F, int l) {
    LAS int* tcls = (LAS int*)(F.lds + MISC_OFF + MO_TCLS); LAS int* ttb = (LAS int*)(F.lds + MISC_OFF + MO_TTB); LAS int* cnts = (LAS int*)(F.lds + MISC_OFF + MO_CNT); LAS int* ntp = (LAS int*)(F.lds + MISC_OFF + MO_NT);
    __syncthreads();
    if (F.tid == 0) { int t = 0;
        for (int c = 0; c < NCLS; ++c) { int n = (int)__hip_atomic_load(F.ctl + CW_CNT + l * 32 + c, RLX_AGENT); if (n > CLS_CAP) n = CLS_CAP; cnts[c] = n;
            for (int j = 0; j * 256 < n && t < MAXTILES; ++j) { tcls[t] = c; ttb[t] = j * 256; ++t; } }
        ntp[0] = t; }
    __syncthreads();
    return ntp[0];
}
__device__ __forceinline__ void phase_moe_gu(Frame& F, int l) {
    rebind(F);
    const int NT = moe_tables(F, l);
    PolMoeGU P; P.tcls = (const LAS int*)(F.lds + MISC_OFF + MO_TCLS); P.ttb = (const LAS int*)(F.lds + MISC_OFF + MO_TTB); P.cnts = (const LAS int*)(F.lds + MISC_OFF + MO_CNT);
    P.NT = NT; P.G = F.G; P.c = F.bid; P.A = (const char*)(F.ws + WS_UA); P.B = (const char*)(F.ws + WS_WGU) + (size_t)l * 16 * 1024 * 2048; P.ri = (const RInfo*)(F.ws + WS_RINFO); P.H = (bf16*)(F.ws + WS_BIG);
    pg8::gemm_phase<PolMoeGU, true>(F.lds, P);
}
__device__ __forceinline__ void phase_moe_down(Frame& F, int l) {
    rebind(F);
    const int NT = moe_tables(F, l);
    PolMoeDown P; P.tcls = (const LAS int*)(F.lds + MISC_OFF + MO_TCLS); P.ttb = (const LAS int*)(F.lds + MISC_OFF + MO_TTB); P.cnts = (const LAS int*)(F.lds + MISC_OFF + MO_CNT);
    P.NT = NT; P.G = F.G; P.c = F.bid; P.A = (const char*)(F.ws + WS_BIG); P.B = (const char*)(F.ws + WS_WD) + (size_t)l * 16 * 1024 * 1024; P.ri = (const RInfo*)(F.ws + WS_RINFO); P.Y = (bf16*)(F.ws + WS_Y);
    pg8::gemm_phase<PolMoeDown, true>(F.lds, P);
}
__device__ __forceinline__ void phase_inproj(Frame& F, int l) {
    rebind(F);
    PolInProj P; P.so.init(T, DINW, F.G, F.bid); P.A = (const char*)(F.ws + WS_UA); P.B = (const char*)(F.ws + WS_WIN) + (size_t)l * DINW * 2048; P.O = (bf16*)(F.ws + WS_BIG);
    pg8::gemm_phase<PolInProj, true>(F.lds, P);
}
__device__ __forceinline__ void phase_outproj(Frame& F, int l) {
    rebind(F);
    PolOutProj P; P.so.init(T, D, F.G, F.bid); P.A = (const char*)(F.ws + WS_UA); P.B = (const char*)(F.ws + WS_WOUT) + (size_t)l * D * 2048; P.C = (bf16*)(F.ws + WS_BIG);
    pg8::gemm_phase<PolOutProj, true>(F.lds, P);
}

#include <cstdlib>
#include <vector>

#define XB_TMO      128
#define XB_XCNT(j)  (256  + 64 * (j))
#define XB_XSUB(j)  (1280 + 64 * (j))
#define XB_XGEN(j)  (2304 + 64 * (j))
#define XB_TOP      3328
#define XB_TOPGEN   3392
#define XCD_BAR_WORDS 3456
#define XB_SPIN_CAP (1u << 18)

__device__ __forceinline__ unsigned xb_ld(unsigned* p)              { return __hip_atomic_load(p, __ATOMIC_RELAXED, __HIP_MEMORY_SCOPE_AGENT); }
__device__ __forceinline__ unsigned xb_add(unsigned* p, unsigned v) { return __hip_atomic_fetch_add(p, v, __ATOMIC_RELAXED, __HIP_MEMORY_SCOPE_AGENT); }
__device__ __forceinline__ unsigned xb_xcc_id() { return (unsigned)__builtin_amdgcn_s_getreg((3 << 11) | 20) & 0xFu; }
#define XB_SPIN(cond, bar) do { unsigned _sp = 0; while (cond) { __builtin_amdgcn_s_sleep(1); \
    if ((++_sp & 255u) == 0u) { if (xb_ld(&(bar)[XB_TMO])) break; if (_sp > XB_SPIN_CAP) { atomicAdd(&(bar)[XB_TMO], 1u); break; } } } } while (0)

struct XcdBarrier {
    unsigned* bar; unsigned x;
    volatile LAS unsigned* st;
};

__device__ __forceinline__ XcdBarrier xcd_barrier_post(unsigned* bar, volatile LAS unsigned* st) {
    XcdBarrier b; b.bar = bar; b.x = xb_xcc_id(); b.st = st;
    if (threadIdx.x == 0) (void)xb_add(&bar[XB_XCNT(b.x)], 1u);
    return b;
}
__device__ __forceinline__ void xcd_barrier_complete(unsigned* bar, unsigned x, unsigned& nloc, unsigned& nx) {
    const unsigned G = gridDim.x * gridDim.y * gridDim.z;
    unsigned sum, cnt, mine, sp = 0u;
    for (;;) {
        sum = 0u; cnt = 0u; mine = 0u;
#pragma unroll
        for (unsigned j = 0; j < 16; ++j) { const unsigned c = xb_ld(&bar[XB_XCNT(j)]); sum += c; cnt += (c > 0u) ? 1u : 0u; mine = (j == x) ? c : mine; }
        if (sum == G) break;
        __builtin_amdgcn_s_sleep(1);
        if ((++sp & 255u) == 0u) { if (xb_ld(&bar[XB_TMO])) break; if (sp > XB_SPIN_CAP) { atomicAdd(&bar[XB_TMO], 1u); break; } }
    }
    nloc = mine > 0u ? mine : 1u; nx = cnt > 0u ? cnt : 1u;
}

__device__ __forceinline__ void xcd_barrier(const XcdBarrier& b) {
    asm volatile("s_waitcnt vmcnt(0)" ::: "memory");
    __syncthreads();
    if (threadIdx.x == 0) {
        unsigned* bar = b.bar;
        __builtin_amdgcn_s_waitcnt(0);
        unsigned nloc = b.st[0], nx = b.st[1];
        if (nloc == 0u) { xcd_barrier_complete(bar, b.x, nloc, nx); b.st[0] = nloc; b.st[1] = nx; }
        const unsigned old = xb_add(&bar[XB_XSUB(b.x)], 1u);
        const unsigned gen = old / nloc;
        if (old + 1u == (gen + 1u) * nloc) {
            __builtin_amdgcn_fence(__ATOMIC_RELEASE, "agent");
            asm volatile("s_waitcnt vmcnt(0)" ::: "memory");
            const unsigned og = xb_add(&bar[XB_TOP], 1u);
            const unsigned tg = og / nx;
            if (og + 1u == (tg + 1u) * nx) xb_add(&bar[XB_TOPGEN], 1u);
            else XB_SPIN(xb_ld(&bar[XB_TOPGEN]) == tg, bar);
            __builtin_amdgcn_fence(__ATOMIC_ACQUIRE, "agent");
            xb_add(&bar[XB_XGEN(b.x)], 1u);
            asm volatile("s_waitcnt vmcnt(0)" ::: "memory");
        } else {
            XB_SPIN(xb_ld(&bar[XB_XGEN(b.x)]) == gen, bar);
            __builtin_amdgcn_fence(__ATOMIC_ACQUIRE, "agent");
            asm volatile("s_waitcnt vmcnt(0)" ::: "memory");
        }
    }
    __syncthreads();
}

enum { PH_PRO = 0, PH_ROWA, PH_INPROJ, PH_MIXER, PH_OUTPROJ, PH_ROWB, PH_MOEGU, PH_MOEDOWN, PH_ROWC };
#ifndef MK_N_LAUNCHES
#define MK_N_LAUNCHES 1
#endif
__device__ __forceinline__ void frame_init(Frame& F, const Args& args, unsigned char* lds) {
    F.lds = (LAS unsigned char*)lds; F.ws = F.ws0 = args.ws; F.ctl = (gu32*)(args.ws + WS_CTL); F.out = F.out0 = args.out;
    F.ap = (KArgs)__builtin_amdgcn_kernarg_segment_ptr();
    F.tid = threadIdx.x; F.lane = F.tid & 63; F.wave = __builtin_amdgcn_readfirstlane(F.tid >> 6); F.G = gridDim.x;
}
#if MK_N_LAUNCHES == 1
__global__ void __launch_bounds__(NTHR, 2) fwd(Args args) {
    extern __shared__ __attribute__((aligned(16))) unsigned char lds[];
    Frame F; frame_init(F, args, lds);
    for (int u = F.tid; u < (LDS_BYTES - MISC_OFF) / 4; u += NTHR) ((LAS unsigned*)(F.lds + MISC_OFF))[u] = 0u;
    __syncthreads();
    const XcdBarrier bar = xcd_barrier_post((unsigned*)(args.ws + WS_CTL) + CW_BAR, (volatile LAS unsigned*)(F.lds + MISC_OFF + MO_BAR));
#define GRID_BAR() do { XcdBarrier bb_ = bar; size_t zo_ = 0; asm volatile("" : "+s"(zo_), "+s"(bb_.x)); bb_.bar = bar.bar + zo_; xcd_barrier(bb_); } while (0)
    phase_prologue(F); GRID_BAR();
    phase_rowA(F); GRID_BAR();
    static_assert(NL == 2, "two layers written out (no runtime layer loop: nothing to hoist out of it)");
#define LAYER(l, LASTL) do { phase_inproj(F, l); GRID_BAR(); phase_mix1(F, l); GRID_BAR(); phase_mix2(F, l); GRID_BAR(); phase_outproj(F, l); GRID_BAR(); phase_rowB(F, l); GRID_BAR(); \
        phase_moe_gu(F, l); GRID_BAR(); phase_moe_down(F, l); GRID_BAR(); phase_rowC(F, l); if (!(LASTL)) GRID_BAR(); } while (0)
    LAYER(0, false);
    LAYER(1, true);
#undef LAYER
}
#else
template <int PH>
__global__ void __launch_bounds__(NTHR, 2) k_phase(Args args) {
    extern __shared__ __attribute__((aligned(16))) unsigned char lds[];
    Frame F; frame_init(F, args, lds);
    const int l = args.l;
    if constexpr (PH == PH_PRO) phase_prologue(F);
    if constexpr (PH == PH_ROWA) phase_rowA(F);
    if constexpr (PH == PH_INPROJ) phase_inproj(F, l);
    if constexpr (PH == PH_MIXER) phase_mixer(F, l);
    if constexpr (PH == PH_OUTPROJ) phase_outproj(F, l);
    if constexpr (PH == PH_ROWB) phase_rowB(F, l);
    if constexpr (PH == PH_MOEGU) phase_moe_gu(F, l);
    if constexpr (PH == PH_MOEDOWN) phase_moe_down(F, l);
    if constexpr (PH == PH_ROWC) phase_rowC(F, l);
}
template <int PH> static bool launch_phase(const Args& a, int grid, hipStream_t stream) {
    static bool attr = false;
    if (!attr) { if (hipFuncSetAttribute((const void*)k_phase<PH>, hipFuncAttributeMaxDynamicSharedMemorySize, LDS_BYTES) != hipSuccess) { fprintf(stderr, "kernel_launch: hipFuncSetAttribute failed (phase %d)\n", PH); return false; } attr = true; }
    hipLaunchKernelGGL(k_phase<PH>, dim3(grid), dim3(NTHR), LDS_BYTES, stream, a);
    const hipError_t le = hipPeekAtLastError();
    if (le != hipSuccess) { fprintf(stderr, "kernel_launch: launch of phase %d failed: %s\n", PH, hipGetErrorName(le)); return false; }
    return true;
}
#endif

extern "C" void kernel_launch(void* const* d_in, const int* in_sizes, int n_in, void* d_out, int out_size, void* d_ws, size_t ws_size, hipStream_t stream) {
    static int grid = 0;
    if (grid == 0) {
        if (n_in != 20 || in_sizes[0] != T * D || out_size != T * D || ws_size < WS_END) { fprintf(stderr, "kernel_launch: unexpected shapes (n_in %d, in0 %d, out %d, ws %zu < %zu)\n", n_in, n_in > 0 ? in_sizes[0] : -1, out_size, ws_size, (size_t)WS_END); grid = -1; return; }
        int dev = 0, cus = 0;
        if (hipGetDevice(&dev) != hipSuccess || hipDeviceGetAttribute(&cus, hipDeviceAttributeMultiprocessorCount, dev) != hipSuccess) { grid = -1; return; }
#if MK_N_LAUNCHES == 1
        if (hipFuncSetAttribute((const void*)fwd, hipFuncAttributeMaxDynamicSharedMemorySize, LDS_BYTES) != hipSuccess) { fprintf(stderr, "kernel_launch: hipFuncSetAttribute failed\n"); grid = -1; return; }
        int per_cu = 0;
        if (hipOccupancyMaxActiveBlocksPerMultiprocessor(&per_cu, (const void*)fwd, NTHR, LDS_BYTES) != hipSuccess || per_cu < 1) { fprintf(stderr, "kernel_launch: occupancy query reports %d workgroups per CU; nothing launched\n", per_cu); grid = -1; return; }
        (void)hipGetLastError();
#endif
        grid = cus;
    }
    if (grid < 0) return;
    if (hipMemsetAsync((char*)d_ws + WS_CTL, 0, CTL_ZERO_BYTES, stream) != hipSuccess) return;
    Args a{};
    for (int i = 0; i < 20; ++i) a.in[i] = (const float*)d_in[i];
    a.out = (float*)d_out; a.ws = (unsigned char*)d_ws; a.l = 0; a.pad = 0;
#if MK_N_LAUNCHES == 1
    hipLaunchKernelGGL(fwd, dim3(grid), dim3(NTHR), LDS_BYTES, stream, a);
    const hipError_t le = hipPeekAtLastError();
    if (le != hipSuccess) fprintf(stderr, "kernel_launch: launch failed: %s\n", hipGetErrorName(le));
#else
#define LP(PH) do { if (!launch_phase<PH>(a, grid, stream)) return; } while (0)
    LP(PH_PRO);
    LP(PH_ROWA);
    for (int l = 0; l < NL; ++l) {
        a.l = l;
        LP(PH_INPROJ); LP(PH_MIXER); LP(PH_OUTPROJ); LP(PH_ROWB); LP(PH_MOEGU); LP(PH_MOEDOWN); LP(PH_ROWC);
    }
#endif
}
```

```cpp
#include <hip/hip_runtime.h>
#include <cstdio>
#include <cstdint>

#define GAS __attribute__((address_space(1)))
#define LAS __attribute__((address_space(3)))
typedef unsigned short bf16;
typedef short bf16x8 __attribute__((ext_vector_type(8)));
typedef float f32x4 __attribute__((ext_vector_type(4)));
typedef float f32x2 __attribute__((ext_vector_type(2)));
typedef unsigned u32x4 __attribute__((ext_vector_type(4)));
typedef unsigned u32x2 __attribute__((ext_vector_type(2)));
typedef GAS unsigned gu32;
#define RLX_AGENT __ATOMIC_RELAXED, __HIP_MEMORY_SCOPE_AGENT
#define LDS_WAIT() asm volatile("s_waitcnt lgkmcnt(0)" ::: "memory")
#define VM_WAIT() asm volatile("s_waitcnt vmcnt(0)" ::: "memory")

constexpr int T = 32768, D = 1024, SEQ = 2048, NL = 2, DINW = 3584, DIN_SRC = 3592;
constexpr int NCLS = 24, CLS_CAP = 32768, MAXTILES = 160;
constexpr float ALPHA = 1.41421356237309505f, LN_EPS = 1e-5f, QSCALE = 0.08838834764831845f;
constexpr int NWAVES = 8, NTHR = 512;

constexpr size_t MiB = 1u << 20;
constexpr size_t WS_CTL = 0, CTL_ZERO_BYTES = 1 * MiB;
constexpr size_t WS_MOD = 1 * MiB;
constexpr size_t WS_GATES = 2 * MiB;
constexpr size_t WS_RINFO = 4 * MiB;
constexpr size_t WS_WIN = 16 * MiB;
constexpr size_t WS_WOUT = 30 * MiB;
constexpr size_t WS_WGU = 34 * MiB;
constexpr size_t WS_WD = 98 * MiB;
constexpr size_t WS_UA = 130 * MiB;
constexpr size_t WS_BIG = 194 * MiB;
constexpr size_t WS_X1 = WS_BIG + 128 * MiB;
constexpr size_t WS_Y = WS_UA;
constexpr size_t WS_CST = WS_BIG + 224 * MiB;
constexpr size_t WS_NPREV = WS_CST + 64 * MiB;
constexpr size_t WS_MST = WS_NPREV + 1 * MiB;
constexpr size_t WS_END = WS_MST + 1 * MiB;
static_assert(WS_END <= 512 * MiB, "d_ws is 512 MiB");
static_assert((size_t)(T + NCLS * 256) * 1024 * 2 <= 128 * MiB, "HID fits below X1");
constexpr int CW_TMO = 0, CW_CODE = 1, CW_CNT = 64, CW_BAR = 4096;

constexpr int RING_BYTES = 131072, MISC_OFF = RING_BYTES, LDS_BYTES = 147456;
constexpr int MO_BAR = 0, MO_TCLS = 64, MO_TTB = 1024, MO_CNT = 2048, MO_NT = 2176, MO_LCNT = 2304, MO_LBASE = 2432, MO_REC = 4096, MO_SG = 8192;

struct RInfo { int token; float wa; float wb; int pad; };

__device__ __forceinline__ unsigned f2bf(float f) { unsigned u = __builtin_bit_cast(unsigned, f); return (u + 0x7fffu + ((u >> 16) & 1u)) >> 16; }
__device__ __forceinline__ unsigned pk2(float lo, float hi) { return f2bf(lo) | (f2bf(hi) << 16); }
__device__ __forceinline__ float bf_lo(unsigned w) { return __builtin_bit_cast(float, w << 16); }
__device__ __forceinline__ float bf_hi(unsigned w) { return __builtin_bit_cast(float, w & 0xffff0000u); }
__device__ __forceinline__ float wave_sum(float v) {
#pragma unroll
    for (int o = 1; o < 64; o <<= 1) v += __shfl_xor(v, o);
    return v;
}
__device__ __forceinline__ float sigmoidf_(float x) { return 1.0f / (1.0f + __expf(-x)); }

__device__ __forceinline__ int opaque_tid() {
    int w = __builtin_amdgcn_readfirstlane(threadIdx.x >> 6); asm volatile("" : "+s"(w));
    int l = __builtin_amdgcn_mbcnt_hi(~0u, __builtin_amdgcn_mbcnt_lo(~0u, 0u)); asm volatile("" : "+v"(l));
    return w * 64 + l; }
namespace pg8 {
constexpr int BM = 256, BK = 64, HALF = 128, HTB = HALF * BK * 2, STAGE_BYTES = 8 * HTB, NXCD = 8, WGM = 8;
__host__ __device__ __forceinline__ int lds_byte(int r, int c) { const int st = (r >> 4) * 2 + (c >> 5), rr = r & 15, cc = c & 31, ob = rr * 64 + cc * 2; return st * 1024 + (ob ^ (((ob >> 9) & 1) << 5)); }
__host__ __device__ __forceinline__ void stage_rc(int b, int& R, int& C) { const int st = b / 1024, sb = b % 1024, swz = sb ^ (((sb >> 9) & 1) << 5); R = (st >> 1) * 16 + swz / 64; C = (st & 1) * 32 + (swz % 64) / 2; }
__host__ __device__ __forceinline__ int perm32(int rho) { const int n = rho >> 4, i = rho & 15; return 8 * (i >> 2) + 4 * n + (i & 3); }
__device__ __forceinline__ unsigned cvt_pk_bf16(float lo, float hi) { unsigned r; asm volatile("v_cvt_pk_bf16_f32 %0, %1, %2" : "=v"(r) : "v"(lo), "v"(hi)); return r; }

__device__ __forceinline__ void stage_rows(int (&sR)[2], int (&sC)[2]) { const int tid = opaque_tid();
#pragma unroll
    for (int i = 0; i < 2; ++i) stage_rc(tid * 16 + i * 8192, sR[i], sC[i]); }
struct StaticOrder {
    int nM, nN, nwg, G, c;
    __device__ void init(int M, int N, int G_, int c_) { nM = M / BM; nN = N / BM; nwg = nM * nN; G = G_; c = c_; }
    __device__ bool next(int i, int& pm, int& pn) const {
        const long L = (long)i * G + c; if (L >= nwg) return false;
        int wgid = (int)L; { const int q = nwg / NXCD, r = nwg % NXCD, xcd = wgid % NXCD, off = wgid / NXCD; wgid = (xcd < r ? xcd * (q + 1) : r * (q + 1) + (xcd - r) * q) + off; }
        const int nig = WGM * nN, gid = wgid / nig, fm = gid * WGM, gsz = (nM - fm) < WGM ? (nM - fm) : WGM;
        pm = fm + ((wgid % nig) % gsz); pn = (wgid % nig) / gsz; return true;
    }
};

template <class P, bool ALIGN_EPI>
__device__ __forceinline__ void gemm_phase(LAS unsigned char* lds, const P& S) {
    const int tid = opaque_tid(), wid = __builtin_amdgcn_readfirstlane(tid >> 6), lane = tid & 63, wr = wid >> 2, wc = wid & 3, fr = lane & 15, fq = lane >> 4;
    constexpr int nt = 16;
    unsigned voffB[2];
#pragma unroll
    for (int i = 0; i < 2; ++i) { int R, C; stage_rc(tid * 16 + i * 8192, R, C); const int Rb = P::PERM ? ((R & ~31) + perm32(R & 31)) : R; voffB[i] = (unsigned)(Rb * P::LDB + C) * 2u; }
    constexpr size_t kstep = (size_t)(BK * 2);
    constexpr size_t hstepB = (size_t)HALF * P::LDB * 2;
    const unsigned ldsw = (unsigned)wid * 1024u;
    const int aoff = lds_byte(wr * 64 + fr, fq * 8), boff = lds_byte(wc * 32 + fr, fq * 8);
#define PG8_SA(b, h) (((b) * 2 + (h)) * HTB)
#define PG8_SB(b, h) ((4 + (b) * 2 + (h)) * HTB)
#define PG8_STAGE(bufoff, gbase, voff) do { _Pragma("unroll") for (int _i = 0; _i < 2; ++_i) \
        __builtin_amdgcn_global_load_lds((const unsigned*)((const char*)(gbase) + (voff)[_i]), (LAS unsigned*)(lds + (bufoff) + ldsw + _i * 8192), 16, 0, 0); } while (0)
#define PG8_LDA(dst, b, h) do { _Pragma("unroll") for (int m = 0; m < 4; ++m) _Pragma("unroll") for (int k = 0; k < 2; ++k) dst[m][k] = *(const LAS bf16x8*)(lds + PG8_SA(b, h) + aoff + m * 2048 + k * 1024); } while (0)
#define PG8_LDB(dst, b, h) do { _Pragma("unroll") for (int n = 0; n < 2; ++n) _Pragma("unroll") for (int k = 0; k < 2; ++k) dst[n][k] = *(const LAS bf16x8*)(lds + PG8_SB(b, h) + boff + n * 2048 + k * 1024); } while (0)
#define PG8_MMA(ai, bj, At, Bt) do { __builtin_amdgcn_s_setprio(1); _Pragma("unroll") for (int m = 0; m < 4; ++m) _Pragma("unroll") for (int n = 0; n < 2; ++n) _Pragma("unroll") for (int k = 0; k < 2; ++k) \
        acc[ai][bj][m][n] = __builtin_amdgcn_mfma_f32_16x16x32_bf16(Bt[n][k], At[m][k], acc[ai][bj][m][n], 0, 0, 0); __builtin_amdgcn_s_setprio(0); } while (0)
#define PG8_WAIT_V(n) asm volatile("s_waitcnt vmcnt(" #n ")" ::: "memory")
#define PG8_WAIT_L(n) asm volatile("s_waitcnt lgkmcnt(" #n ")" ::: "memory")
#define PG8_BAR __builtin_amdgcn_s_barrier()
#define PG8_SCHED __builtin_amdgcn_sched_barrier(0)
    typename P::U cur, nxt; int ui = 0;
    if (!S.next(0, cur)) return;
    f32x4 acc[2][2][4][2];
#pragma unroll
    for (int a = 0; a < 2; ++a)
#pragma unroll
        for (int b = 0; b < 2; ++b)
#pragma unroll
            for (int m = 0; m < 4; ++m)
#pragma unroll
                for (int n = 0; n < 2; ++n) acc[a][b][m][n] = (f32x4){0.f, 0.f, 0.f, 0.f};
    bf16x8 At[4][2], B0[2][2], B1[2][2];
    unsigned offC[2][2];
    S.a_off(cur, offC);
    const char* cA = S.a_base(cur); const char* cB = S.b_base(cur, 0);
    PG8_STAGE(PG8_SB(0, 0), cB, voffB); PG8_STAGE(PG8_SB(0, 1), cB + hstepB, voffB); PG8_STAGE(PG8_SA(0, 0), cA, offC[0]); PG8_STAGE(PG8_SA(0, 1), cA, offC[1]);
    if (wr == 1) PG8_BAR;
    PG8_WAIT_V(2); PG8_BAR;
    PG8_STAGE(PG8_SB(1, 0), cB + kstep, voffB); PG8_STAGE(PG8_SA(1, 0), cA + kstep, offC[0]); PG8_STAGE(PG8_SB(1, 1), cB + hstepB + kstep, voffB);
    PG8_WAIT_V(6); PG8_BAR;
    for (;;) {
        const bool has_next = S.next(ui + 1, nxt);
        const char* nA = cA; const char* nB = cB;
        if (has_next) { nA = S.a_base(nxt); nB = S.b_base(nxt, 0); }
        unsigned o2[2][2];
#pragma nounroll
        for (int t = 0; t < nt; t += 2) {
            const bool last = (t == nt - 2);
            const char* a1 = cA + (size_t)(t + 1) * kstep;
            const char* a2 = last ? nA : cA + (size_t)(t + 2) * kstep; const char* b2 = last ? nB : S.b_base(cur, t + 2);
            const char* a3 = a2 + kstep; const char* b3 = b2 + kstep;
            if (P::GATHER && last && has_next) S.a_off(nxt, o2);
            else {
#pragma unroll
                for (int h = 0; h < 2; ++h)
#pragma unroll
                    for (int i = 0; i < 2; ++i) o2[h][i] = offC[h][i]; }
            PG8_LDB(B0, 0, 0); PG8_LDB(B1, 0, 1); PG8_SCHED; PG8_LDA(At, 0, 0); PG8_STAGE(PG8_SA(1, 1), a1, offC[1]);
            PG8_WAIT_V(8); PG8_WAIT_L(0); PG8_BAR; PG8_MMA(0, 0, At, B0); PG8_MMA(0, 1, At, B1); PG8_BAR; PG8_SCHED;
            PG8_LDA(At, 0, 1); PG8_STAGE(PG8_SB(0, 0), b2, voffB); PG8_STAGE(PG8_SB(0, 1), b2 + hstepB, voffB); PG8_STAGE(PG8_SA(0, 0), a2, o2[0]);
            PG8_WAIT_V(8); PG8_WAIT_L(0); PG8_BAR; PG8_MMA(1, 0, At, B0); PG8_MMA(1, 1, At, B1); PG8_BAR; PG8_SCHED;
            PG8_LDB(B0, 1, 0); PG8_LDB(B1, 1, 1); PG8_SCHED; PG8_LDA(At, 1, 0); PG8_STAGE(PG8_SA(0, 1), a2, o2[1]);
            PG8_WAIT_V(8); PG8_WAIT_L(0); PG8_BAR; PG8_MMA(0, 0, At, B0); PG8_MMA(0, 1, At, B1); PG8_BAR; PG8_SCHED;
            PG8_LDA(At, 1, 1); PG8_STAGE(PG8_SB(1, 0), b3, voffB); PG8_STAGE(PG8_SB(1, 1), b3 + hstepB, voffB); PG8_STAGE(PG8_SA(1, 0), a3, o2[0]);
            PG8_WAIT_V(8); PG8_WAIT_L(0); PG8_BAR; PG8_MMA(1, 0, At, B0); PG8_MMA(1, 1, At, B1); PG8_BAR; PG8_SCHED;
        }
        if constexpr (ALIGN_EPI) { if (wr == 0) PG8_BAR; }
        S.epi(acc, cur, wr, wc, fr, fq);
        if (!has_next) break;
#pragma unroll
        for (int a = 0; a < 2; ++a)
#pragma unroll
            for (int b = 0; b < 2; ++b)
#pragma unroll
                for (int m = 0; m < 4; ++m)
#pragma unroll
                    for (int n = 0; n < 2; ++n) acc[a][b][m][n] = (f32x4){0.f, 0.f, 0.f, 0.f};
        cur = nxt; cA = nA; cB = nB; ++ui;
        if constexpr (P::GATHER) {
#pragma unroll
            for (int h = 0; h < 2; ++h)
#pragma unroll
                for (int i = 0; i < 2; ++i) offC[h][i] = o2[h][i]; }
        if constexpr (ALIGN_EPI) { if (wr == 1) PG8_BAR; }
    }
    PG8_WAIT_V(0);
    if constexpr (!ALIGN_EPI) { if (wr == 0) PG8_BAR; }
    PG8_BAR;
#undef PG8_SA
#undef PG8_SB
#undef PG8_STAGE
#undef PG8_LDA
#undef PG8_LDB
#undef PG8_MMA
#undef PG8_WAIT_V
#undef PG8_WAIT_L
#undef PG8_BAR
#undef PG8_SCHED
}
}

struct Args { const float* in[20]; float* out; unsigned char* ws; int l, pad; };
struct ArgsG { const GAS float* in[20]; float* out; unsigned char* ws; int l, pad; };
typedef __attribute__((address_space(4))) const ArgsG* KArgs;
typedef const GAS float* gin;
struct Frame {
    LAS unsigned char* lds;
    gu32* ctl;
    unsigned char* ws; unsigned char* ws0;
    KArgs ap;
    float* out; float* out0;
    int tid, lane, wave, G, bid;
    __device__ __forceinline__ gin in(int i) const { return ap->in[i]; }
};
__device__ __forceinline__ void rebind(Frame& F) {
    F.tid = opaque_tid(); F.lane = F.tid & 63; F.wave = __builtin_amdgcn_readfirstlane(F.tid >> 6);
    KArgs ap = (KArgs)__builtin_amdgcn_kernarg_segment_ptr(); asm volatile("" : "+s"(ap)); F.ap = ap;
    size_t z = 0; asm volatile("" : "+s"(z));
    F.ws = F.ws0 + z; F.ctl = (gu32*)(F.ws + WS_CTL); F.out = F.out0 + z;
    int g = gridDim.x; asm volatile("" : "+s"(g)); F.G = g;
    int b = blockIdx.x; asm volatile("" : "+s"(b)); F.bid = b;
}
enum { I_X = 0, I_C, I_WADA, I_BADA, I_WIN, I_BG, I_MHW, I_WCONV, I_WOUT, I_LN1G, I_LN1B, I_WGRP, I_BGRP, I_WR, I_BR, I_WGATE, I_WUP, I_WDOWN, I_LN2G, I_LN2B };

struct UnitS { int pm, pn; };
struct PolInProj {
    typedef UnitS U; static constexpr bool PERM = true, GATHER = false; static constexpr int LDB = 1024;
    pg8::StaticOrder so; const char* A; const char* B; bf16* O;
    __device__ __forceinline__ bool next(int i, U& u) const { return so.next(i, u.pm, u.pn); }
    __device__ __forceinline__ const char* a_base(const U& u) const { return A + (size_t)u.pm * (256 * 2048); }
    __device__ __forceinline__ void a_off(const U&, unsigned (&o)[2][2]) const { int sR[2], sC[2]; pg8::stage_rows(sR, sC);
#pragma unroll
        for (int h = 0; h < 2; ++h)
#pragma unroll
            for (int i = 0; i < 2; ++i) o[h][i] = (unsigned)((h * 128 + sR[i]) * 1024 + sC[i]) * 2u; }
    __device__ __forceinline__ const char* b_base(const U& u, int kt) const { return B + (size_t)u.pn * (256 * 2048) + (size_t)kt * 128; }
    __device__ __forceinline__ void epi(const f32x4 (&acc)[2][2][4][2], const U& u, int wr, int wc, int fr, int fq) const {
        const int row0 = u.pm * 256 + wr * 64 + fr, col0 = u.pn * 256 + wc * 32 + 8 * fq;
#pragma unroll
        for (int ai = 0; ai < 2; ++ai)
#pragma unroll
            for (int m = 0; m < 4; ++m) { bf16* rowp = O + (size_t)(row0 + ai * 128 + m * 16) * DINW + col0;
#pragma unroll
                for (int bj = 0; bj < 2; ++bj) { const f32x4 v0 = acc[ai][bj][m][0], v1 = acc[ai][bj][m][1];
                    u32x4 w; w.x = pg8::cvt_pk_bf16(v0[0], v0[1]); w.y = pg8::cvt_pk_bf16(v0[2], v0[3]); w.z = pg8::cvt_pk_bf16(v1[0], v1[1]); w.w = pg8::cvt_pk_bf16(v1[2], v1[3]);
                    *(u32x4*)(rowp + bj * 128) = w; } }
    }
};
struct PolOutProj {
    typedef UnitS U; static constexpr bool PERM = true, GATHER = false; static constexpr int LDB = 1024;
    pg8::StaticOrder so; const char* A; const char* B; bf16* C;
    __device__ __forceinline__ bool next(int i, U& u) const { return so.next(i, u.pm, u.pn); }
    __device__ __forceinline__ const char* a_base(const U& u) const { return A + (size_t)u.pm * (256 * 2048); }
    __device__ __forceinline__ void a_off(const U&, unsigned (&o)[2][2]) const { int sR[2], sC[2]; pg8::stage_rows(sR, sC);
#pragma unroll
        for (int h = 0; h < 2; ++h)
#pragma unroll
            for (int i = 0; i < 2; ++i) o[h][i] = (unsigned)((h * 128 + sR[i]) * 1024 + sC[i]) * 2u; }
    __device__ __forceinline__ const char* b_base(const U& u, int kt) const { return B + (size_t)u.pn * (256 * 2048) + (size_t)kt * 128; }
    __device__ __forceinline__ void epi(const f32x4 (&acc)[2][2][4][2], const U& u, int wr, int wc, int fr, int fq) const {
        const int row0 = u.pm * 256 + wr * 64 + fr, col0 = u.pn * 256 + wc * 32 + 8 * fq;
#pragma unroll
        for (int ai = 0; ai < 2; ++ai)
#pragma unroll
            for (int m = 0; m < 4; ++m) { bf16* rowp = C + (size_t)(row0 + ai * 128 + m * 16) * D + col0;
#pragma unroll
                for (int bj = 0; bj < 2; ++bj) { const f32x4 v0 = acc[ai][bj][m][0], v1 = acc[ai][bj][m][1];
                    u32x4 w; w.x = pg8::cvt_pk_bf16(v0[0], v0[1]); w.y = pg8::cvt_pk_bf16(v0[2], v0[3]); w.z = pg8::cvt_pk_bf16(v1[0], v1[1]); w.w = pg8::cvt_pk_bf16(v1[2], v1[3]);
                    *(u32x4*)(rowp + bj * 128) = w; } }
    }
};
struct UnitM { int tile, pn, cls, tb, cnt; };
__device__ __forceinline__ int pair_a(int p) { return p < 3 ? 0 : (p < 5 ? 1 : 2); }
__device__ __forceinline__ int pair_b(int p) { return p < 3 ? p + 1 : (p < 5 ? p - 1 : 3); }
struct PolMoeGU {
    typedef UnitM U; static constexpr bool PERM = true, GATHER = true; static constexpr int LDB = 1024;
    const LAS int* tcls; const LAS int* ttb; const LAS int* cnts; int NT, G, c;
    const char* A; const char* B  ; const RInfo* ri; bf16* H;
    __device__ __forceinline__ bool next(int i, U& u) const { const int L = i * G + c; const int tile = L >> 3; if (tile >= NT) return false;
        u.tile = tile; u.pn = L & 7; u.cls = tcls[tile]; u.tb = ttb[tile]; u.cnt = cnts[u.cls]; return true; }
    __device__ __forceinline__ const char* a_base(const U&) const { return A; }
    __device__ __forceinline__ void a_off(const U& u, unsigned (&o)[2][2]) const { int sR[2], sC[2]; pg8::stage_rows(sR, sC);
#pragma unroll
        for (int h = 0; h < 2; ++h)
#pragma unroll
            for (int i = 0; i < 2; ++i) { int rr = u.tb + h * 128 + sR[i]; if (rr >= u.cnt) rr = 0; const int tok = ri[(size_t)u.cls * CLS_CAP + rr].token; o[h][i] = (unsigned)tok * 2048u + (unsigned)sC[i] * 2u; } }
    __device__ __forceinline__ const char* b_base(const U& u, int kt) const { const int g = u.cls / 6, p = u.cls - g * 6, e = (u.pn >> 2) ? pair_b(p) : pair_a(p);
        return B + ((size_t)(g * 4 + e) * 1024 + (size_t)(u.pn & 3) * 256) * 2048 + (size_t)kt * 128; }
    __device__ __forceinline__ void epi(const f32x4 (&acc)[2][2][4][2], const U& u, int wr, int wc, int fr, int fq) const {
        const int slot = u.pn >> 2, ct = u.pn & 3;
#pragma unroll
        for (int ai = 0; ai < 2; ++ai)
#pragma unroll
            for (int m = 0; m < 4; ++m) { const int r = ai * 128 + wr * 64 + m * 16 + fr, rr = u.tb + r; const bool valid = rr < u.cnt;
                float w = 0.f; if (valid) { const RInfo* q = ri + (size_t)u.cls * CLS_CAP + rr; w = slot ? q->wb : q->wa; }
                float hv[8];
#pragma unroll
                for (int n = 0; n < 2; ++n)
#pragma unroll
                    for (int j = 0; j < 4; ++j) { const float g = acc[ai][0][m][n][j], up = acc[ai][1][m][n][j]; hv[n * 4 + j] = g * __builtin_amdgcn_rcpf(1.0f + __expf(-g)) * up * w; }
                u32x4 o; o.x = pg8::cvt_pk_bf16(hv[0], hv[1]); o.y = pg8::cvt_pk_bf16(hv[2], hv[3]); o.z = pg8::cvt_pk_bf16(hv[4], hv[5]); o.w = pg8::cvt_pk_bf16(hv[6], hv[7]);
                if (valid) *(u32x4*)(H + (size_t)(u.tile * 256 + r) * 1024 + slot * 512 + ct * 128 + wc * 32 + 8 * fq) = o; }
    }
};
struct PolMoeDown {
    typedef UnitM U; static constexpr bool PERM = true, GATHER = false; static constexpr int LDB = 512;
    const LAS int* tcls; const LAS int* ttb; const LAS int* cnts; int NT, G, c;
    const char* A  ; const char* B  ; const RInfo* ri; bf16* Y;
    __device__ __forceinline__ bool next(int i, U& u) const { const int L = i * G + c; const int tile = L >> 2; if (tile >= NT) return false;
        u.tile = tile; u.pn = L & 3; u.cls = tcls[tile]; u.tb = ttb[tile]; u.cnt = cnts[u.cls]; return true; }
    __device__ __forceinline__ const char* a_base(const U& u) const { return A + (size_t)u.tile * (256 * 2048); }
    __device__ __forceinline__ void a_off(const U&, unsigned (&o)[2][2]) const { int sR[2], sC[2]; pg8::stage_rows(sR, sC);
#pragma unroll
        for (int h = 0; h < 2; ++h)
#pragma unroll
            for (int i = 0; i < 2; ++i) o[h][i] = (unsigned)((h * 128 + sR[i]) * 1024 + sC[i]) * 2u; }
    __device__ __forceinline__ const char* b_base(const U& u, int kt) const { const int g = u.cls / 6, p = u.cls - g * 6, e = (kt >> 3) ? pair_b(p) : pair_a(p);
        return B + ((size_t)(g * 4 + e) * 1024 + (size_t)u.pn * 256) * 1024 + (size_t)(kt & 7) * 128; }
    __device__ __forceinline__ void epi(const f32x4 (&acc)[2][2][4][2], const U& u, int wr, int wc, int fr, int fq) const {
#pragma unroll
        for (int ai = 0; ai < 2; ++ai)
#pragma unroll
            for (int m = 0; m < 4; ++m) { const int r = ai * 128 + wr * 64 + m * 16 + fr, rr = u.tb + r; const bool valid = rr < u.cnt;
                if (valid) { const int tok = ri[(size_t)u.cls * CLS_CAP + rr].token; bf16* rowp = Y + (size_t)tok * D + u.pn * 256 + wc * 32 + 8 * fq;
#pragma unroll
                    for (int bj = 0; bj < 2; ++bj) { const f32x4 v0 = acc[ai][bj][m][0], v1 = acc[ai][bj][m][1];
                        u32x4 w; w.x = pg8::cvt_pk_bf16(v0[0], v0[1]); w.y = pg8::cvt_pk_bf16(v0[2], v0[3]); w.z = pg8::cvt_pk_bf16(v1[0], v1[1]); w.w = pg8::cvt_pk_bf16(v1[2], v1[3]);
                        *(u32x4*)(rowp + bj * 128) = w; } } }
    }
};

__device__ __forceinline__ void transpose_item(gin W, int ldw, int k0, int n0, bf16* WT, int ldk, int drow0, float scale, LAS float* scr, int lane) {
#pragma unroll 8
    for (int i = 0; i < 32; ++i) { const int kk = 2 * i + (lane >> 5); scr[kk * 33 + (lane & 31)] = W[(size_t)(k0 + kk) * ldw + n0 + (lane & 31)]; }
    LDS_WAIT(); asm volatile("" ::: "memory");
    const int c = lane & 7;
#pragma unroll
    for (int j = 0; j < 4; ++j) { const int n = (lane >> 3) + 8 * j; const LAS float* s = scr + (8 * c) * 33 + n;
        u32x4 o; o.x = pk2(s[0 * 33] * scale, s[1 * 33] * scale); o.y = pk2(s[2 * 33] * scale, s[3 * 33] * scale); o.z = pk2(s[4 * 33] * scale, s[5 * 33] * scale); o.w = pk2(s[6 * 33] * scale, s[7 * 33] * scale);
        *(u32x4*)(WT + (size_t)(drow0 + n) * ldk + k0 + 8 * c) = o; }
    LDS_WAIT(); asm volatile("" ::: "memory");
}
__device__ __forceinline__ void phase_prologue(Frame& F) {
    rebind(F);
    {
        LAS float* scr = (LAS float*)(F.lds + F.wave * 16384);
        const int gw = F.bid * NWAVES + F.wave, NGW = F.G * NWAVES;
        constexpr int I_IN = NL * 16 * 112, I_OUT = NL * 16 * 32, I_G = NL * 16 * 256, I_DN = NL * 16 * 256;
        constexpr int NITEMS = I_IN + I_OUT + 2 * I_G + I_DN;
        for (int it = gw; it < NITEMS; it += NGW) {
            int r = it;
            if (r < I_IN) { const int l = r / 1792, q = r % 1792, kb = q / 112, nb = q % 112, nd = nb * 32, ns = nd < 2048 ? nd : nd + 8;
                transpose_item(F.in(I_WIN) + (size_t)l * D * DIN_SRC, DIN_SRC, kb * 64, ns, (bf16*)(F.ws + WS_WIN) + (size_t)l * DINW * D, D, nd, nd < 512 ? QSCALE : 1.0f, scr, F.lane); continue; }
            r -= I_IN;
            if (r < I_OUT) { const int l = r / 512, q = r % 512, kb = q / 32, nb = q % 32;
                transpose_item(F.in(I_WOUT) + (size_t)l * D * D, D, kb * 64, nb * 32, (bf16*)(F.ws + WS_WOUT) + (size_t)l * D * D, D, nb * 32, 1.0f, scr, F.lane); continue; }
            r -= I_OUT;
            if (r < 2 * I_G) { const int up = r >= I_G; if (up) r -= I_G; const int mat = r / 256, q = r % 256, kb = q / 16, nb = q % 16, f0 = nb * 32;
                transpose_item(F.in(up ? I_WUP : I_WGATE) + (size_t)mat * D * 512, 512, kb * 64, f0, (bf16*)(F.ws + WS_WGU) + (size_t)mat * 1024 * 1024, 1024, (f0 >> 7) * 256 + (f0 & 127) + (up ? 128 : 0), 1.0f, scr, F.lane); continue; }
            r -= 2 * I_G;
            { const int mat = r / 256, q = r % 256, kb = q / 32, nb = q % 32;
                transpose_item(F.in(I_WDOWN) + (size_t)mat * 512 * D, D, kb * 64, nb * 32, (bf16*)(F.ws + WS_WD) + (size_t)mat * 1024 * 512, 512, nb * 32, 1.0f, scr, F.lane); }
        }
    }
    __syncthreads();
    {
        LAS float* cond = (LAS float*)F.lds;
        LAS float* red = (LAS float*)(F.lds + 65536);
        bool have = false;
        for (int un = F.bid; un < NL * 192; un += F.G) {
            if (!have) { for (int i = F.tid; i < 16 * 1024; i += NTHR) { const float c = F.in(I_C)[i]; cond[i] = c * sigmoidf_(c); } have = true; }
            __syncthreads();
            const int l = un / 192, n0 = (un % 192) * 32, n = F.tid & 31, ks = F.tid >> 5;
            gin W = F.in(I_WADA) + (size_t)l * D * 6144 + n0 + n;
            float acc[16];
#pragma unroll
            for (int b = 0; b < 16; ++b) acc[b] = 0.f;
            for (int kk = 0; kk < 64; ++kk) { const int k = ks * 64 + kk; const float w = W[(size_t)k * 6144];
#pragma unroll
                for (int b = 0; b < 16; ++b) acc[b] += cond[b * 1024 + k] * w; }
#pragma unroll
            for (int b = 0; b < 16; ++b) red[(ks * 16 + b) * 32 + n] = acc[b];
            __syncthreads();
            { const int b = F.tid >> 5; float s = 0.f;
#pragma unroll
              for (int k2 = 0; k2 < 16; ++k2) s += red[(k2 * 16 + b) * 32 + n];
              ((float*)(F.ws + WS_MOD))[((size_t)l * 16 + b) * 6144 + n0 + n] = s + F.in(I_BADA)[l * 6144 + n0 + n]; }
        }
    }
}

__device__ __forceinline__ void stage_cols_T(LAS float* dst, gin src, int ld, int col0, int NC, int tid) {
    for (int idx = tid; idx < NC * 1024; idx += NTHR) { const int k = idx / NC, c = idx - k * NC; dst[c * 1024 + k] = src[(size_t)k * ld + col0 + c]; }
}
__device__ __forceinline__ float dpp_xadd(float v, const int ctrl_is) {
    return v;
}
#define DPP_ADD(v, ctrl) ((v) + __builtin_bit_cast(float, __builtin_amdgcn_update_dpp(0, __builtin_bit_cast(int, (v)), (ctrl), 0xf, 0xf, true)))
__device__ __forceinline__ float wave_sum_dpp(float v) {
    v = DPP_ADD(v, 0xB1);
    v = DPP_ADD(v, 0x4E);
    v = DPP_ADD(v, 0x141);
    v = DPP_ADD(v, 0x140);
    const int iv = __builtin_bit_cast(int, v);
    const float a = __builtin_bit_cast(float, __builtin_amdgcn_readlane(iv, 0)), b = __builtin_bit_cast(float, __builtin_amdgcn_readlane(iv, 16));
    const float c = __builtin_bit_cast(float, __builtin_amdgcn_readlane(iv, 32)), d = __builtin_bit_cast(float, __builtin_amdgcn_readlane(iv, 48));
    return (a + b) + (c + d);
}
template <int NC> __device__ __forceinline__ float wave_colsum(const float (&part)[NC], LAS float* red, int lane) {
#pragma unroll
    for (int c = 0; c < NC; ++c) red[c * 64 + lane] = part[c];
    const int cc = lane < NC ? lane : NC - 1; float s = 0.f;
#pragma unroll
    for (int i = 0; i < 16; ++i) { const f32x4 v = *(const LAS f32x4*)(red + cc * 64 + i * 4); s += (v[0] + v[1]) + (v[2] + v[3]); }
    return s;
}
__device__ __forceinline__ float lane_bcast(float v, const int l) { return __builtin_bit_cast(float, __builtin_amdgcn_readlane(__builtin_bit_cast(int, v), l)); }
__device__ __forceinline__ void load_row_f32(f32x4 (&x)[4], const float* p, int lane) {
#pragma unroll
    for (int j = 0; j < 4; ++j) x[j] = *(const f32x4*)(p + 256 * j + 4 * lane);
}
__device__ __forceinline__ void load_row_bf16(f32x4 (&x)[4], const bf16* p, int lane) {
#pragma unroll
    for (int j = 0; j < 4; ++j) { const u32x2 w = *(const u32x2*)(p + 256 * j + 4 * lane); x[j] = (f32x4){bf_lo(w.x), bf_hi(w.x), bf_lo(w.y), bf_hi(w.y)}; }
}
__device__ __forceinline__ void store_row_bf16(bf16* p, const f32x4 (&x)[4], int lane) {
#pragma unroll
    for (int j = 0; j < 4; ++j) { u32x2 w; w.x = pg8::cvt_pk_bf16(x[j][0], x[j][1]); w.y = pg8::cvt_pk_bf16(x[j][2], x[j][3]); *(u32x2*)(p + 256 * j + 4 * lane) = w; }
}
__device__ __forceinline__ void modulate_gates(Frame& F, const f32x4 (&xo)[4], int m, int lg, const LAS float* wgT, LAS float* red) {
    const float* mod = (const float*)(F.ws + WS_MOD) + ((size_t)lg * 16 + (m >> 11)) * 6144;
    f32x4 u[4];
#pragma unroll
    for (int j = 0; j < 4; ++j) { const int col = 256 * j + 4 * F.lane; const f32x4 sh = *(const f32x4*)(mod + col), sc = *(const f32x4*)(mod + 1024 + col); u[j] = xo[j] * (1.0f + sc) + sh; }
    store_row_bf16((bf16*)(F.ws + WS_UA) + (size_t)m * D, u, F.lane);
    float g[8];
#pragma unroll
    for (int c = 0; c < 8; ++c) { float sacc = 0.f;
#pragma unroll
        for (int j = 0; j < 4; ++j) { const f32x4 w = *(const LAS f32x4*)(wgT + c * 1024 + 256 * j + 4 * F.lane); sacc += (u[j][0] * w[0] + u[j][1] * w[1]) + (u[j][2] * w[2] + u[j][3] * w[3]); }
        g[c] = sacc; }
    const float val = wave_colsum<8>(g, red, F.lane);
    if (F.lane < 8) ((float*)(F.ws + WS_GATES))[(size_t)m * 8 + F.lane] = val + F.in(I_BG)[lg * 8 + F.lane];
}
__device__ __forceinline__ void ln_row(f32x4 (&z)[4], gin g, gin b, int lane) {
    float sacc = 0.f;
#pragma unroll
    for (int j = 0; j < 4; ++j) sacc += (z[j][0] + z[j][1]) + (z[j][2] + z[j][3]);
    const float mean = wave_sum_dpp(sacc) * (1.0f / D); float q = 0.f;
#pragma unroll
    for (int j = 0; j < 4; ++j) { z[j] = z[j] - mean; q += (z[j][0] * z[j][0] + z[j][1] * z[j][1]) + (z[j][2] * z[j][2] + z[j][3] * z[j][3]); }
    const float rstd = 1.0f / sqrtf(wave_sum_dpp(q) * (1.0f / D) + LN_EPS);
#pragma unroll
    for (int j = 0; j < 4; ++j) { const int col = 256 * j + 4 * lane; const f32x4 gg = *(const GAS f32x4*)(g + col), bb = *(const GAS f32x4*)(b + col); z[j] = z[j] * rstd * gg + bb; }
}
__device__ __forceinline__ void phase_rowA(Frame& F) {
    rebind(F);
    LAS float* wgT = (LAS float*)F.lds; LAS float* red = (LAS float*)(F.lds + 32768 + F.wave * 5120);
    stage_cols_T(wgT, F.in(I_WIN), DIN_SRC, 2048, 8, F.tid);
    __syncthreads();
    const int gw = F.bid * NWAVES + F.wave, NGW = F.G * NWAVES;
    f32x4 xn[4];
#pragma unroll
    for (int j = 0; j < 4; ++j) xn[j] = *(const GAS f32x4*)(F.in(I_X) + (size_t)(gw < T ? gw : 0) * D + 256 * j + 4 * F.lane);
#pragma nounroll
    for (int m = gw; m < T; m += NGW) {
        f32x4 x[4];
#pragma unroll
        for (int j = 0; j < 4; ++j) x[j] = xn[j];
        const int mn = (m + NGW < T) ? m + NGW : m;
#pragma unroll
        for (int j = 0; j < 4; ++j) xn[j] = *(const GAS f32x4*)(F.in(I_X) + (size_t)mn * D + 256 * j + 4 * F.lane);
        modulate_gates(F, x, m, 0, wgT, red);
    }
}
__device__ __forceinline__ void phase_rowB(Frame& F, int l) {
    rebind(F);
    LAS float* wrT = (LAS float*)F.lds;
    LAS float* red = (LAS float*)(F.lds + 81920 + F.wave * 5120);
    LAS int* lcnt = (LAS int*)(F.lds + MISC_OFF + MO_LCNT);
    LAS int* lbase = (LAS int*)(F.lds + MISC_OFF + MO_LBASE);
    LAS int* rec = (LAS int*)(F.lds + MISC_OFF + MO_REC);
    stage_cols_T(wrT, F.in(I_WGRP) + (size_t)l * D * 4, 4, 0, 4, F.tid);
    stage_cols_T(wrT + 4 * 1024, F.in(I_WR) + (size_t)l * D * 16, 16, 0, 16, F.tid);
    if (F.tid < NCLS) lcnt[F.tid] = 0;
    __syncthreads();
    const bf16* xprev = (const bf16*)F.out;
    const bf16* mix = (const bf16*)(F.ws + WS_BIG);
    bf16* x1p = (bf16*)(F.ws + WS_X1);
    RInfo* ri = (RInfo*)(F.ws + WS_RINFO);
    for (int rb = F.bid; rb < T / 128; rb += F.G) {
        const float* mod = (const float*)(F.ws + WS_MOD) + ((size_t)l * 16 + ((rb * 128) >> 11)) * 6144;
        const int mrow0 = rb * 128 + F.wave * 16;
        f32x4 xn[4]; u32x2 mn[4];
#define ROWB_FETCH(M) do { \
            if (l == 0) { _Pragma("unroll") for (int j = 0; j < 4; ++j) xn[j] = *(const GAS f32x4*)(F.in(I_X) + (size_t)(M) * D + 256 * j + 4 * F.lane); } \
            else load_row_bf16(xn, xprev + (size_t)(M) * D, F.lane); \
            _Pragma("unroll") for (int j = 0; j < 4; ++j) mn[j] = *(const u32x2*)(mix + (size_t)(M) * D + 256 * j + 4 * F.lane); } while (0)
        ROWB_FETCH(mrow0);
#pragma nounroll
        for (int i = 0; i < 16; ++i) {
            const int m = mrow0 + i, rl = F.wave * 16 + i;
            f32x4 z[4];
#pragma unroll
            for (int j = 0; j < 4; ++j) { const f32x4 gt = *(const f32x4*)(mod + 2048 + 256 * j + 4 * F.lane); const f32x4 mv = (f32x4){bf_lo(mn[j].x), bf_hi(mn[j].x), bf_lo(mn[j].y), bf_hi(mn[j].y)}; z[j] = xn[j] * ALPHA + (1.0f + gt) * mv; }
            ROWB_FETCH(m + (i < 15 ? 1 : 0));
            ln_row(z, F.in(I_LN1G) + l * D, F.in(I_LN1B) + l * D, F.lane);
            store_row_bf16(x1p + (size_t)m * D, z, F.lane);
#pragma unroll
            for (int j = 0; j < 4; ++j) { const int col = 256 * j + 4 * F.lane; const f32x4 sh = *(const f32x4*)(mod + 3072 + col), sc = *(const f32x4*)(mod + 4096 + col); z[j] = z[j] * (1.0f + sc) + sh; }
            store_row_bf16((bf16*)(F.ws + WS_UA) + (size_t)m * D, z, F.lane);
            float gl[4]; int gi = 0;
            { float part[4];
#pragma unroll
              for (int c = 0; c < 4; ++c) { float sacc = 0.f;
#pragma unroll
                for (int j = 0; j < 4; ++j) { const f32x4 w = *(const LAS f32x4*)(wrT + c * 1024 + 256 * j + 4 * F.lane); sacc += (z[j][0] * w[0] + z[j][1] * w[1]) + (z[j][2] * w[2] + z[j][3] * w[3]); }
                part[c] = sacc; }
              const float tot = wave_colsum<4>(part, red, F.lane);
#pragma unroll
              for (int j = 0; j < 4; ++j) gl[j] = lane_bcast(tot, j) + F.in(I_BGRP)[l * 4 + j]; }
            float gm = gl[0];
#pragma unroll
            for (int j = 1; j < 4; ++j) if (gl[j] > gm) { gm = gl[j]; gi = j; }
            float den = 0.f;
#pragma unroll
            for (int j = 0; j < 4; ++j) den += __expf(gl[j] - gm);
            const float grp_w = 1.0f / den;
            float el[4];
            { float part[4]; const LAS float* wsel = wrT + (4 + gi * 4) * 1024;
#pragma unroll
              for (int c = 0; c < 4; ++c) { float sacc = 0.f;
#pragma unroll
                for (int j = 0; j < 4; ++j) { const f32x4 w = *(const LAS f32x4*)(wsel + c * 1024 + 256 * j + 4 * F.lane); sacc += (z[j][0] * w[0] + z[j][1] * w[1]) + (z[j][2] * w[2] + z[j][3] * w[3]); }
                part[c] = sacc; }
              const float tot = wave_colsum<4>(part, red, F.lane);
#pragma unroll
              for (int e = 0; e < 4; ++e) el[e] = lane_bcast(tot, e) + F.in(I_BR)[l * 16 + gi * 4 + e]; }
            int i1 = 0; float v1 = el[0];
#pragma unroll
            for (int e = 1; e < 4; ++e) if (el[e] > v1) { v1 = el[e]; i1 = e; }
            int i2 = -1; float v2 = -3.0e38f;
#pragma unroll
            for (int e = 0; e < 4; ++e) if (e != i1 && el[e] > v2) { v2 = el[e]; i2 = e; }
            const float ex = __expf(v2 - v1), w1 = grp_w / (1.0f + ex), w2 = grp_w * ex / (1.0f + ex);
            const int ea = i1 < i2 ? i1 : i2, eb = i1 < i2 ? i2 : i1; const float wa = i1 < i2 ? w1 : w2, wb = i1 < i2 ? w2 : w1;
            const int p = ea == 0 ? eb - 1 : (ea == 1 ? eb + 1 : 5), cls = gi * 6 + p;
            if (F.lane == 0) { const int lr = __hip_atomic_fetch_add(lcnt + cls, 1, __ATOMIC_RELAXED, __HIP_MEMORY_SCOPE_WORKGROUP);
                rec[rl * 4 + 0] = cls; rec[rl * 4 + 1] = lr; rec[rl * 4 + 2] = __builtin_bit_cast(int, wa); rec[rl * 4 + 3] = __builtin_bit_cast(int, wb); }
        }
#undef ROWB_FETCH
        __syncthreads();
        if (F.tid < NCLS) { const int n = lcnt[F.tid]; lbase[F.tid] = n ? (int)__hip_atomic_fetch_add(F.ctl + CW_CNT + l * 32 + F.tid, (unsigned)n, RLX_AGENT) : 0; }
        __syncthreads();
        if (F.tid < 128) { const int cls = rec[F.tid * 4], pos = lbase[cls] + rec[F.tid * 4 + 1];
            RInfo r; r.token = rb * 128 + F.tid; r.wa = __builtin_bit_cast(float, rec[F.tid * 4 + 2]); r.wb = __builtin_bit_cast(float, rec[F.tid * 4 + 3]); r.pad = 0;
            ri[(size_t)cls * CLS_CAP + pos] = r; }
        __syncthreads();
        if (F.tid < NCLS) lcnt[F.tid] = 0;
        __syncthreads();
    }
}
__device__ __forceinline__ void phase_rowC(Frame& F, int l) {
    rebind(F);
    LAS float* wgT = (LAS float*)F.lds; LAS float* red = (LAS float*)(F.lds + 32768 + F.wave * 5120);
    if (l + 1 < NL) stage_cols_T(wgT, F.in(I_WIN) + (size_t)(l + 1) * D * DIN_SRC, DIN_SRC, 2048, 8, F.tid);
    __syncthreads();
    const bf16* x1p = (const bf16*)(F.ws + WS_X1); const bf16* yp = (const bf16*)(F.ws + WS_Y);
    const int gw = F.bid * NWAVES + F.wave, NGW = F.G * NWAVES;
    u32x2 xr[4], yr[4];
    { const int m0 = gw < T ? gw : 0;
#pragma unroll
      for (int j = 0; j < 4; ++j) { xr[j] = *(const u32x2*)(x1p + (size_t)m0 * D + 256 * j + 4 * F.lane); yr[j] = *(const u32x2*)(yp + (size_t)m0 * D + 256 * j + 4 * F.lane); } }
#pragma nounroll
    for (int m = gw; m < T; m += NGW) {
        const float* mod = (const float*)(F.ws + WS_MOD) + ((size_t)l * 16 + (m >> 11)) * 6144;
        f32x4 z[4];
#pragma unroll
        for (int j = 0; j < 4; ++j) { const f32x4 gt = *(const f32x4*)(mod + 5120 + 256 * j + 4 * F.lane);
            const f32x4 xv = (f32x4){bf_lo(xr[j].x), bf_hi(xr[j].x), bf_lo(xr[j].y), bf_hi(xr[j].y)}, yv = (f32x4){bf_lo(yr[j].x), bf_hi(yr[j].x), bf_lo(yr[j].y), bf_hi(yr[j].y)};
            z[j] = xv * ALPHA + (1.0f + gt) * yv; }
        { const int mn = (m + NGW < T) ? m + NGW : m;
#pragma unroll
          for (int j = 0; j < 4; ++j) { xr[j] = *(const u32x2*)(x1p + (size_t)mn * D + 256 * j + 4 * F.lane); yr[j] = *(const u32x2*)(yp + (size_t)mn * D + 256 * j + 4 * F.lane); } }
        ln_row(z, F.in(I_LN2G) + l * D, F.in(I_LN2B) + l * D, F.lane);
        if (l + 1 < NL) { store_row_bf16((bf16*)F.out + (size_t)m * D, z, F.lane); modulate_gates(F, z, m, l + 1, wgT, red); }
        else {
#pragma unroll
            for (int j = 0; j < 4; ++j) *(f32x4*)(F.out + (size_t)m * D + 256 * j + 4 * F.lane) = z[j]; }
    }
}

__device__ __forceinline__ void mlstm_naive_unit(Frame& F, int l, int bh) {
    const int b = bh >> 2, h = bh & 3, tid = F.tid, v = tid >> 2, kp = tid & 3;
    LAS float* Qs = (LAS float*)F.lds; LAS float* Ks = Qs + 64 * 128; LAS float* Vs = Ks + 64 * 128; LAS float* Hb = Vs + 64 * 128;
    LAS float* sg = (LAS float*)(F.lds + MISC_OFF + MO_SG);
    const bf16* proj = (const bf16*)(F.ws + WS_BIG); const float* gates = (const float*)(F.ws + WS_GATES);
    bf16* outp = (bf16*)(F.ws + WS_UA);
    float C[32], nn[32];
#pragma unroll
    for (int j = 0; j < 32; ++j) { C[j] = 0.f; nn[j] = 0.f; }
    float mst = 0.f;
    for (int blk = 0; blk < SEQ / 64; ++blk) {
        const int tok0 = b * SEQ + blk * 64;
#pragma unroll
        for (int i = 0; i < 2; ++i) { const int idx = tid + i * NTHR, row = idx >> 4, c8 = idx & 15; const bf16* p = proj + (size_t)(tok0 + row) * DINW + h * 128 + c8 * 8;
            const u32x4 q = *(const u32x4*)p, k = *(const u32x4*)(p + 512), vv = *(const u32x4*)(p + 1024);
            LAS float* dq = Qs + row * 128 + c8 * 8; LAS float* dk = Ks + row * 128 + c8 * 8; LAS float* dv = Vs + row * 128 + c8 * 8;
#pragma unroll
            for (int e = 0; e < 4; ++e) { dq[2 * e] = bf_lo(q[e]); dq[2 * e + 1] = bf_hi(q[e]); dk[2 * e] = bf_lo(k[e]); dk[2 * e + 1] = bf_hi(k[e]); dv[2 * e] = bf_lo(vv[e]); dv[2 * e + 1] = bf_hi(vv[e]); } }
        if (tid < 64) { const float ip = gates[(size_t)(tok0 + tid) * 8 + h], fp = gates[(size_t)(tok0 + tid) * 8 + 4 + h];
            const float lf = fminf(fp, 0.f) - log1pf(__expf(-fabsf(fp)));
            sg[tid * 2] = lf; sg[tid * 2 + 1] = ip; }
        __syncthreads();
        for (int t = 0; t < 64; ++t) {
            const float lf = sg[t * 2], ig = sg[t * 2 + 1];
            const float mnew = fmaxf(lf + mst, ig), fd = __expf(lf + mst - mnew), ii = __expf(ig - mnew); mst = mnew;
            const float vv = Vs[t * 128 + v] * ii;
            float hp = 0.f, dp = 0.f;
#pragma unroll
            for (int j4 = 0; j4 < 8; ++j4) { const f32x4 kk = *(const LAS f32x4*)(Ks + t * 128 + kp * 32 + j4 * 4), qq = *(const LAS f32x4*)(Qs + t * 128 + kp * 32 + j4 * 4);
#pragma unroll
                for (int e = 0; e < 4; ++e) { const int j = j4 * 4 + e; C[j] = fd * C[j] + vv * kk[e]; nn[j] = fd * nn[j] + ii * kk[e]; hp += C[j] * qq[e]; dp += nn[j] * qq[e]; } }
            hp += __shfl_xor(hp, 1); hp += __shfl_xor(hp, 2); dp += __shfl_xor(dp, 1); dp += __shfl_xor(dp, 2);
            const float hv = hp / fmaxf(fabsf(dp), __expf(-mst));
            if (kp == 0) Hb[t * 128 + v] = hv;
        }
        __syncthreads();
        { const int t = tid >> 3, part = tid & 7; float x[16]; float s = 0.f;
#pragma unroll
          for (int j = 0; j < 16; ++j) { x[j] = Hb[t * 128 + part * 16 + j]; s += x[j]; }
          s += __shfl_xor(s, 1); s += __shfl_xor(s, 2); s += __shfl_xor(s, 4);
          const float mean = s * (1.0f / 128.0f); float q = 0.f;
#pragma unroll
          for (int j = 0; j < 16; ++j) { x[j] -= mean; q += x[j] * x[j]; }
          q += __shfl_xor(q, 1); q += __shfl_xor(q, 2); q += __shfl_xor(q, 4);
          const float rstd = 1.0f / sqrtf(q * (1.0f / 128.0f) + LN_EPS);
          const bf16* op = proj + (size_t)(tok0 + t) * DINW + 1536 + h * 128 + part * 16; gin wn = F.in(I_MHW) + l * 512 + h * 128 + part * 16;
          const u32x4 o0 = *(const u32x4*)op, o1 = *(const u32x4*)(op + 8);
          float r[16];
#pragma unroll
          for (int e = 0; e < 4; ++e) { r[2 * e] = bf_lo(o0[e]); r[2 * e + 1] = bf_hi(o0[e]); r[8 + 2 * e] = bf_lo(o1[e]); r[8 + 2 * e + 1] = bf_hi(o1[e]); }
#pragma unroll
          for (int j = 0; j < 16; ++j) r[j] = x[j] * rstd * wn[j] * sigmoidf_(r[j]);
          u32x4 w0, w1;
#pragma unroll
          for (int e = 0; e < 4; ++e) { w0[e] = pk2(r[2 * e], r[2 * e + 1]); w1[e] = pk2(r[8 + 2 * e], r[8 + 2 * e + 1]); }
          bf16* dp2 = outp + (size_t)(tok0 + t) * D + h * 128 + part * 16; *(u32x4*)dp2 = w0; *(u32x4*)(dp2 + 8) = w1; }
        __syncthreads();
    }
}

#define LBAR() do { asm volatile("s_waitcnt lgkmcnt(0)" ::: "memory"); __builtin_amdgcn_s_barrier(); asm volatile("" ::: "memory"); } while (0)
__device__ __forceinline__ void mlstm_chunk_unit(Frame& F, int l, int bh) {
    const int b = bh >> 2, h = bh & 3, tid = F.tid, lane = F.lane, w = F.wave, fr = lane & 15, fq = lane >> 4;
    LAS unsigned char* L = F.lds;
    constexpr int QS = 0, KS = 17408, KW = 34816, VS = 53248, PS = 71680, CB = 80896, SC = 115712, NV = 119808, HS = 0;
    constexpr int QST = 272, WST = 288, TST = 144, HST = 132;
    typedef short v4i16_t __attribute__((ext_vector_type(4)));
#define TRFRAG(base, c, ks) __builtin_shufflevector( \
        __builtin_amdgcn_ds_read_tr16_b64_v4i16((LAS v4i16_t*)(L + (base) + (32 * (ks) + 8 * fq + ((lane & 15) >> 2)) * WST + (16 * (c) + 4 * (lane & 3)) * 2)), \
        __builtin_amdgcn_ds_read_tr16_b64_v4i16((LAS v4i16_t*)(L + (base) + (32 * (ks) + 8 * fq + 4 + ((lane & 15) >> 2)) * WST + (16 * (c) + 4 * (lane & 3)) * 2)), 0, 1, 2, 3, 4, 5, 6, 7)
    const bf16* proj = (const bf16*)(F.ws + WS_BIG); const float* gates = (const float*)(F.ws + WS_GATES); bf16* outp = (bf16*)(F.ws + WS_UA);
    const int tokb = b * SEQ;
    for (int i = lane; i < 16 * QST / 16; i += 64) *(LAS u32x4*)(L + CB + w * 16 * QST + i * 16) = (u32x4){0u, 0u, 0u, 0u};
    if (tid < 128) ((LAS float*)(L + NV))[tid] = 0.f;
    f32x4 acc2[8];
#pragma unroll
    for (int kt = 0; kt < 8; ++kt) acc2[kt] = (f32x4){0.f, 0.f, 0.f, 0.f};
    f32x4 nacc = (f32x4){0.f, 0.f, 0.f, 0.f};
    const bf16x8 ones = (bf16x8){0x3F80, 0x3F80, 0x3F80, 0x3F80, 0x3F80, 0x3F80, 0x3F80, 0x3F80};
    float m_st = 0.f;
    float g_ip = gates[(size_t)(tokb + lane) * 8 + h], g_fp = gates[(size_t)(tokb + lane) * 8 + 4 + h];
#define MLSTM_SCALARS(sbn) do { \
        const float lf_ = fminf(g_fp, 0.f) - log1pf(__expf(-fabsf(g_fp))); float bc_ = lf_; \
        _Pragma("unroll") for (int d_ = 1; d_ < 64; d_ <<= 1) { const float v_ = __shfl_up(bc_, d_); if (lane >= d_) bc_ += v_; } \
        const float r_ = g_ip - bc_; float pm_ = r_; \
        _Pragma("unroll") for (int d_ = 1; d_ < 64; d_ <<= 1) { const float v_ = __shfl_up(pm_, d_); if (lane >= d_) pm_ = fmaxf(pm_, v_); } \
        const float gtot_ = __shfl(bc_, 63), pm63_ = __shfl(pm_, 63); \
        const float M_ = fmaxf(m_st, pm_), Mx_ = fmaxf(m_st, pm63_); \
        (sbn)[lane] = r_; (sbn)[64 + lane] = M_; (sbn)[128 + lane] = __expf(m_st - M_); (sbn)[192 + lane] = __expf(-(bc_ + M_)); (sbn)[256 + lane] = __expf(r_ - Mx_); \
        if (lane == 0) (sbn)[320] = __expf(m_st - Mx_); \
        m_st = gtot_ + Mx_; } while (0)
    if (w == 0) MLSTM_SCALARS((LAS float*)(L + SC));
    const int prow = 8 * w + (lane >> 4), pch = lane & 15;
    u32x4 rq[2], rk[2], rv[2], ro[2], ro2[2];
#pragma unroll
    for (int i = 0; i < 2; ++i) { const bf16* p = proj + (size_t)(tokb + prow + 4 * i) * DINW + h * 128 + pch * 8; rq[i] = *(const u32x4*)p; rk[i] = *(const u32x4*)(p + 512); rv[i] = *(const u32x4*)(p + 1024); }
    { const bf16* p = proj + (size_t)(tokb + (tid >> 3)) * DINW + 1536 + h * 128 + (tid & 7) * 16; ro[0] = *(const u32x4*)p; ro[1] = *(const u32x4*)(p + 8); }
    ro2[0] = ro[0]; ro2[1] = ro[1];
    __syncthreads();
    for (int c = 0; c < SEQ / 64; ++c) {
        const LAS float* sb = (const LAS float*)(L + SC + (c & 1) * 2048);
        LAS float* sbn = (LAS float*)(L + SC + ((c + 1) & 1) * 2048);
        const int tok0 = tokb + c * 64;
        const bool more = (c + 1) < SEQ / 64;
#pragma unroll
        for (int i = 0; i < 2; ++i) { const int row = prow + 4 * i; const float wu = sb[256 + row];
            *(LAS u32x4*)(L + QS + row * QST + pch * 16) = rq[i]; *(LAS u32x4*)(L + KS + row * QST + pch * 16) = rk[i]; *(LAS u32x4*)(L + VS + row * WST + pch * 16) = rv[i];
            u32x4 kw;
#pragma unroll
            for (int e = 0; e < 4; ++e) kw[e] = pk2(bf_lo(rk[i][e]) * wu, bf_hi(rk[i][e]) * wu);
            *(LAS u32x4*)(L + KW + row * WST + pch * 16) = kw; }
        const int tokn = more ? tok0 + 64 : tok0;
        g_ip = gates[(size_t)(tokn + lane) * 8 + h]; g_fp = gates[(size_t)(tokn + lane) * 8 + 4 + h];
        LBAR();
#pragma unroll
        for (int i = 0; i < 2; ++i) { const bf16* p = proj + (size_t)(tokn + prow + 4 * i) * DINW + h * 128 + pch * 8; rq[i] = *(const u32x4*)p; rk[i] = *(const u32x4*)(p + 512); rv[i] = *(const u32x4*)(p + 1024); }
        { const bf16* p = proj + (size_t)(tokn + (tid >> 3)) * DINW + 1536 + h * 128 + (tid & 7) * 16; ro2[0] = *(const u32x4*)p; ro2[1] = *(const u32x4*)(p + 8); }
        { const int tt = w >> 1;
#pragma unroll
          for (int j = 0; j < 2; ++j) { const int ts = 2 * (w & 1) + j; f32x4 sa = (f32x4){0.f, 0.f, 0.f, 0.f};
            if (ts <= tt) {
#pragma unroll
                for (int ks = 0; ks < 4; ++ks) { const bf16x8 a = *(const LAS bf16x8*)(L + QS + (tt * 16 + fr) * QST + ks * 64 + fq * 16), bb = *(const LAS bf16x8*)(L + KS + (ts * 16 + fr) * QST + ks * 64 + fq * 16);
                    sa = __builtin_amdgcn_mfma_f32_16x16x32_bf16(a, bb, sa, 0, 0, 0); } }
            const int si = ts * 16 + fr; const float rs = sb[si];
#pragma unroll
            for (int rg = 0; rg < 4; ++rg) { const int ti = tt * 16 + 4 * fq + rg; const float pw = sa[rg] * __expf(rs - sb[64 + ti]);
                *(LAS unsigned short*)(L + PS + ti * TST + si * 2) = (unsigned short)f2bf(si <= ti ? pw : 0.f); } } }
        LBAR();
        { const int t = tid >> 3, part = tid & 7; const u32x4 pp = *(const LAS u32x4*)(L + PS + t * TST + part * 16); float d1 = 0.f, d2 = 0.f;
#pragma unroll
          for (int e = 0; e < 4; ++e) d1 += bf_lo(pp[e]) + bf_hi(pp[e]);
#pragma unroll
          for (int i = 0; i < 2; ++i) { const u32x4 qq = *(const LAS u32x4*)(L + QS + t * QST + part * 32 + i * 16);
#pragma unroll
            for (int e = 0; e < 4; ++e) { const f32x2 nv = *(const LAS f32x2*)(L + NV + (part * 16 + i * 8 + 2 * e) * 4); d2 += bf_lo(qq[e]) * nv[0] + bf_hi(qq[e]) * nv[1]; } }
          d1 += __shfl_xor(d1, 1); d1 += __shfl_xor(d1, 2); d1 += __shfl_xor(d1, 4); d2 += __shfl_xor(d2, 1); d2 += __shfl_xor(d2, 2); d2 += __shfl_xor(d2, 4);
          const float den = d1 + sb[128 + t] * d2;
          if (part == 0) ((LAS float*)(L + SC + (c & 1) * 2048))[384 + t] = 1.0f / fmaxf(fabsf(den), sb[192 + t]); }
        f32x4 n1[4], nI[4]; bf16x8 vf[2];
#pragma unroll
        for (int ks = 0; ks < 2; ++ks) vf[ks] = TRFRAG(VS, w, ks);
#pragma unroll
        for (int t4 = 0; t4 < 4; ++t4) { n1[t4] = (f32x4){0.f, 0.f, 0.f, 0.f}; nI[t4] = (f32x4){0.f, 0.f, 0.f, 0.f};
#pragma unroll
            for (int ks = 0; ks < 2; ++ks) if (ks * 32 <= t4 * 16 + 15) { const bf16x8 a = *(const LAS bf16x8*)(L + PS + (t4 * 16 + fr) * TST + ks * 64 + fq * 16); n1[t4] = __builtin_amdgcn_mfma_f32_16x16x32_bf16(a, vf[ks], n1[t4], 0, 0, 0); } }
        { bf16x8 cf[4];
#pragma unroll
          for (int ks = 0; ks < 4; ++ks) cf[ks] = *(const LAS bf16x8*)(L + CB + (w * 16 + fr) * QST + ks * 64 + fq * 16);
#pragma unroll
          for (int t4 = 0; t4 < 4; ++t4)
#pragma unroll
            for (int ks = 0; ks < 4; ++ks) { const bf16x8 a = *(const LAS bf16x8*)(L + QS + (t4 * 16 + fr) * QST + ks * 64 + fq * 16); nI[t4] = __builtin_amdgcn_mfma_f32_16x16x32_bf16(a, cf[ks], nI[t4], 0, 0, 0); } }
        LBAR();
#pragma unroll
        for (int t4 = 0; t4 < 4; ++t4)
#pragma unroll
            for (int rg = 0; rg < 4; ++rg) { const int ti = t4 * 16 + 4 * fq + rg; ((LAS float*)(L + HS))[ti * HST + w * 16 + fr] = n1[t4][rg] + sb[128 + ti] * nI[t4][rg]; }
        { const float dec = sb[320];
#pragma unroll
          for (int kt = 0; kt < 8; ++kt) { acc2[kt] = acc2[kt] * dec;
            if (kt == w) nacc = nacc * dec;
#pragma unroll
            for (int ks = 0; ks < 2; ++ks) { const bf16x8 a = TRFRAG(KW, kt, ks); acc2[kt] = __builtin_amdgcn_mfma_f32_16x16x32_bf16(a, vf[ks], acc2[kt], 0, 0, 0);
                if (kt == w) nacc = __builtin_amdgcn_mfma_f32_16x16x32_bf16(a, ones, nacc, 0, 0, 0); }
            u32x2 wv; wv.x = pk2(acc2[kt][0], acc2[kt][1]); wv.y = pk2(acc2[kt][2], acc2[kt][3]);
            *(LAS u32x2*)(L + CB + (w * 16 + fr) * QST + (kt * 16 + 4 * fq) * 2) = wv; }
          if (fr == 0) *(LAS f32x4*)(L + NV + (w * 16 + 4 * fq) * 4) = nacc; }
        if (w == 0 && more) MLSTM_SCALARS(sbn);
        LBAR();
        { const int t = tid >> 3, part = tid & 7; const float dinv = sb[384 + t]; float x[16]; float sm = 0.f;
#pragma unroll
          for (int i = 0; i < 4; ++i) { const f32x4 hv = *(const LAS f32x4*)(L + HS + (t * HST + part * 16 + i * 4) * 4);
#pragma unroll
            for (int e = 0; e < 4; ++e) { x[i * 4 + e] = hv[e] * dinv; sm += x[i * 4 + e]; } }
          sm += __shfl_xor(sm, 1); sm += __shfl_xor(sm, 2); sm += __shfl_xor(sm, 4);
          const float mean = sm * (1.0f / 128.0f); float qv = 0.f;
#pragma unroll
          for (int j = 0; j < 16; ++j) { x[j] -= mean; qv += x[j] * x[j]; }
          qv += __shfl_xor(qv, 1); qv += __shfl_xor(qv, 2); qv += __shfl_xor(qv, 4);
          const float rstd = 1.0f / sqrtf(qv * (1.0f / 128.0f) + LN_EPS);
          gin wn = F.in(I_MHW) + l * 512 + h * 128 + part * 16;
          float rr[16];
#pragma unroll
          for (int e = 0; e < 4; ++e) { rr[2 * e] = bf_lo(ro[0][e]); rr[2 * e + 1] = bf_hi(ro[0][e]); rr[8 + 2 * e] = bf_lo(ro[1][e]); rr[8 + 2 * e + 1] = bf_hi(ro[1][e]); }
#pragma unroll
          for (int j = 0; j < 16; ++j) rr[j] = x[j] * rstd * wn[j] * sigmoidf_(rr[j]);
          u32x4 w0, w1;
#pragma unroll
          for (int e = 0; e < 4; ++e) { w0[e] = pk2(rr[2 * e], rr[2 * e + 1]); w1[e] = pk2(rr[8 + 2 * e], rr[8 + 2 * e + 1]); }
          bf16* dp2 = outp + (size_t)(tok0 + t) * D + h * 128 + part * 16; *(u32x4*)dp2 = w0; *(u32x4*)(dp2 + 8) = w1; }
        ro[0] = ro2[0]; ro[1] = ro2[1];
        LBAR();
    }
#undef MLSTM_SCALARS
#undef TRFRAG
}

#define TRFRAG2(base, stride, c, ks) __builtin_shufflevector( \
        __builtin_amdgcn_ds_read_tr16_b64_v4i16((LAS v4i16_t*)(L + (base) + (32 * (ks) + 8 * fq + ((lane & 15) >> 2)) * (stride) + (16 * (c) + 4 * (lane & 3)) * 2)), \
        __builtin_amdgcn_ds_read_tr16_b64_v4i16((LAS v4i16_t*)(L + (base) + (32 * (ks) + 8 * fq + 4 + ((lane & 15) >> 2)) * (stride) + (16 * (c) + 4 * (lane & 3)) * 2)), 0, 1, 2, 3, 4, 5, 6, 7)
typedef short v4i16_t __attribute__((ext_vector_type(4)));
__device__ __forceinline__ void mlstm_state_unit(Frame& F, int l, int unit) {
    const int bh = unit >> 1, vq = unit & 1, b = bh >> 2, h = bh & 3, tid = F.tid, lane = F.lane, w = F.wave, fr = lane & 15, fq = lane >> 4;
    LAS unsigned char* L = F.lds;
    constexpr int KW = 0, VS = 18432, ST = 27648, BUF = 45056, WST = 288, VST = 144, SST = 272;
    constexpr int RS = 2 * BUF, GS = RS + 8192;
    const bf16* proj = (const bf16*)(F.ws + WS_BIG); const float* gates = (const float*)(F.ws + WS_GATES);
    bf16* cst = (bf16*)(F.ws + WS_CST); float* nprev = (float*)(F.ws + WS_NPREV); float* mstp = (float*)(F.ws + WS_MST);
    const int tokb = b * SEQ, prow = 8 * w + (lane >> 4), pch = lane & 15, vrow = tid >> 3, vch = tid & 7;
    const bf16x8 ones = (bf16x8){0x3F80, 0x3F80, 0x3F80, 0x3F80, 0x3F80, 0x3F80, 0x3F80, 0x3F80};
    f32x4 acc[4], nacc = (f32x4){0.f, 0.f, 0.f, 0.f};
#pragma unroll
    for (int vt = 0; vt < 4; ++vt) acc[vt] = (f32x4){0.f, 0.f, 0.f, 0.f};
#pragma unroll
    for (int cc = 0; cc < 4; ++cc) { const int c = 4 * w + cc; const size_t tk = (size_t)(tokb + c * 64 + lane) * 8;
        const float ip = gates[tk + h], fp = gates[tk + 4 + h];
        const float lf = fminf(fp, 0.f) - log1pf(__expf(-fabsf(fp))); float bc = lf;
#pragma unroll
        for (int d = 1; d < 64; d <<= 1) { const float v = __shfl_up(bc, d); if (lane >= d) bc += v; }
        const float r = ip - bc; float pm = r;
#pragma unroll
        for (int d = 1; d < 64; d <<= 1) { const float v = __shfl_up(pm, d); if (lane >= d) pm = fmaxf(pm, v); }
        ((LAS float*)(L + RS))[c * 64 + lane] = r;
        if (lane == 63) { ((LAS float*)(L + GS))[2 * c] = bc; ((LAS float*)(L + GS))[2 * c + 1] = pm; } }
    float m_st = 0.f;
    u32x4 rk[2], rv;
#pragma unroll
    for (int i = 0; i < 2; ++i) rk[i] = *(const u32x4*)(proj + (size_t)(tokb + prow + 4 * i) * DINW + 512 + h * 128 + pch * 8);
    rv = *(const u32x4*)(proj + (size_t)(tokb + vrow) * DINW + 1024 + h * 128 + vq * 64 + vch * 8);
    __syncthreads();
    for (int c = 0; c < SEQ / 64; ++c) {
        const int tok0 = tokb + c * 64, buf = (c & 1) * BUF;
        const float gtot = ((const LAS float*)(L + GS))[2 * c], Mx = fmaxf(m_st, ((const LAS float*)(L + GS))[2 * c + 1]), dec = __expf(m_st - Mx);
        if (vq == 0) { if (tid == 0) mstp[bh * 32 + c] = m_st; if (fr == 0) *(f32x4*)(nprev + (size_t)(bh * 32 + c) * 128 + w * 16 + 4 * fq) = nacc; }
#pragma unroll
        for (int vt = 0; vt < 4; ++vt) { u32x2 wv; wv.x = pg8::cvt_pk_bf16(acc[vt][0], acc[vt][1]); wv.y = pg8::cvt_pk_bf16(acc[vt][2], acc[vt][3]);
            *(LAS u32x2*)(L + buf + ST + (vt * 16 + fr) * SST + (w * 16 + 4 * fq) * 2) = wv; }
#pragma unroll
        for (int i = 0; i < 2; ++i) { const int row = prow + 4 * i; const float wu = __expf(((const LAS float*)(L + RS))[c * 64 + row] - Mx); u32x4 kw;
#pragma unroll
            for (int e = 0; e < 4; ++e) kw[e] = pg8::cvt_pk_bf16(bf_lo(rk[i][e]) * wu, bf_hi(rk[i][e]) * wu);
            *(LAS u32x4*)(L + buf + KW + row * WST + pch * 16) = kw; }
        *(LAS u32x4*)(L + buf + VS + vrow * VST + vch * 16) = rv;
        const int tokn = (c + 1 < SEQ / 64) ? tok0 + 64 : tok0;
#pragma unroll
        for (int i = 0; i < 2; ++i) rk[i] = *(const u32x4*)(proj + (size_t)(tokn + prow + 4 * i) * DINW + 512 + h * 128 + pch * 8);
        rv = *(const u32x4*)(proj + (size_t)(tokn + vrow) * DINW + 1024 + h * 128 + vq * 64 + vch * 8);
        LBAR();
#pragma unroll
        for (int i = 0; i < 2; ++i) { const int row = (tid >> 4) + 32 * i, ch = tid & 15; const u32x4 x = *(const LAS u32x4*)(L + buf + ST + row * SST + ch * 16);
          *(u32x4*)(cst + ((size_t)(bh * 32 + c) * 128 + vq * 64 + row) * 128 + ch * 8) = x; }
        { bf16x8 af[2];
#pragma unroll
          for (int ks = 0; ks < 2; ++ks) af[ks] = TRFRAG2(buf + KW, WST, w, ks);
          nacc = nacc * dec;
#pragma unroll
          for (int ks = 0; ks < 2; ++ks) nacc = __builtin_amdgcn_mfma_f32_16x16x32_bf16(af[ks], ones, nacc, 0, 0, 0);
#pragma unroll
          for (int vt = 0; vt < 4; ++vt) { acc[vt] = acc[vt] * dec;
#pragma unroll
            for (int ks = 0; ks < 2; ++ks) { const bf16x8 bfr = TRFRAG2(buf + VS, VST, vt, ks); acc[vt] = __builtin_amdgcn_mfma_f32_16x16x32_bf16(af[ks], bfr, acc[vt], 0, 0, 0); } } }
        m_st = gtot + Mx;
    }
    LBAR();
}

__device__ __forceinline__ void mlstm_out_phase(Frame& F, int l) {
    const int tid = F.tid, lane = F.lane, w = F.wave, fr = lane & 15, fq = lane >> 4;
    LAS unsigned char* L = F.lds;
    constexpr int QS = 0, KS = 17408, VS = 34816, PS = 53248, CB = 62464, SC = 97280, NV = 99328, HS = 0;
    constexpr int QST = 272, WST = 288, TST = 144, HST = 132;
    constexpr int NCH = 64 * (SEQ / 64);
    const bf16* proj = (const bf16*)(F.ws + WS_BIG); const float* gates = (const float*)(F.ws + WS_GATES); bf16* outp = (bf16*)(F.ws + WS_UA);
    const bf16* cst = (const bf16*)(F.ws + WS_CST); const float* nprev = (const float*)(F.ws + WS_NPREV); const float* mstp = (const float*)(F.ws + WS_MST);
    const int prow = 8 * w + (lane >> 4), pch = lane & 15;
    int cid = F.bid; if (cid >= NCH) return;
    u32x4 rq[2], rk[2], rv[2], ro[2], ro2[2], rc[4]; f32x4 rn = (f32x4){0.f, 0.f, 0.f, 0.f}; float g_ip, g_fp, g_m;
#define MLO_FETCH(CID, RO) do { const int bh_ = (CID) >> 5, c_ = (CID) & 31, h_ = bh_ & 3, tk_ = (bh_ >> 2) * SEQ + c_ * 64; \
        _Pragma("unroll") for (int i = 0; i < 2; ++i) { const bf16* p = proj + (size_t)(tk_ + prow + 4 * i) * DINW + h_ * 128 + pch * 8; rq[i] = *(const u32x4*)p; rk[i] = *(const u32x4*)(p + 512); rv[i] = *(const u32x4*)(p + 1024); } \
        { const bf16* p = proj + (size_t)(tk_ + (tid >> 3)) * DINW + 1536 + h_ * 128 + (tid & 7) * 16; RO[0] = *(const u32x4*)p; RO[1] = *(const u32x4*)(p + 8); } \
        { const bf16* p = cst + ((size_t)(CID) * 128 + (tid >> 2)) * 128 + (tid & 3) * 32; _Pragma("unroll") for (int j = 0; j < 4; ++j) rc[j] = *(const u32x4*)(p + j * 8); } \
        rn = *(const f32x4*)(nprev + (size_t)(CID) * 128 + (tid & 31) * 4); \
        g_ip = gates[(size_t)(tk_ + lane) * 8 + h_]; g_fp = gates[(size_t)(tk_ + lane) * 8 + 4 + h_]; g_m = __hip_atomic_load(mstp + (CID), RLX_AGENT); } while (0)
    MLO_FETCH(cid, ro);
    ro2[0] = ro[0]; ro2[1] = ro[1];
    for (;;) {
        const int bh = cid >> 5, c = cid & 31, h = bh & 3, tok0 = (bh >> 2) * SEQ + c * 64;
        const int nxt = cid + F.G; const bool more = nxt < NCH; const int cidn = more ? nxt : cid;
        LAS float* sb = (LAS float*)(L + SC);
#pragma unroll
        for (int i = 0; i < 2; ++i) { const int row = prow + 4 * i;
            *(LAS u32x4*)(L + QS + row * QST + pch * 16) = rq[i]; *(LAS u32x4*)(L + KS + row * QST + pch * 16) = rk[i]; *(LAS u32x4*)(L + VS + row * WST + pch * 16) = rv[i]; }
#pragma unroll
        for (int j = 0; j < 4; ++j) *(LAS u32x4*)(L + CB + (tid >> 2) * QST + (tid & 3) * 64 + j * 16) = rc[j];
        if (tid < 32) *(LAS f32x4*)(L + NV + tid * 16) = rn;
        if (w == 0) {
            const float m_st = g_m;
            const float lf = fminf(g_fp, 0.f) - log1pf(__expf(-fabsf(g_fp))); float bc = lf;
#pragma unroll
            for (int d = 1; d < 64; d <<= 1) { const float v = __shfl_up(bc, d); if (lane >= d) bc += v; }
            const float r = g_ip - bc; float pm = r;
#pragma unroll
            for (int d = 1; d < 64; d <<= 1) { const float v = __shfl_up(pm, d); if (lane >= d) pm = fmaxf(pm, v); }
            const float M = fmaxf(m_st, pm);
            sb[lane] = r; sb[64 + lane] = M; sb[128 + lane] = __expf(m_st - M); sb[192 + lane] = __expf(-(bc + M)); }
        LBAR();
        MLO_FETCH(cidn, ro2);
        { const int tt = w >> 1;
#pragma unroll
          for (int j = 0; j < 2; ++j) { const int ts = 2 * (w & 1) + j; f32x4 sa = (f32x4){0.f, 0.f, 0.f, 0.f};
            if (ts <= tt) {
#pragma unroll
                for (int ks = 0; ks < 4; ++ks) { const bf16x8 a = *(const LAS bf16x8*)(L + QS + (tt * 16 + fr) * QST + ks * 64 + fq * 16), bb = *(const LAS bf16x8*)(L + KS + (ts * 16 + fr) * QST + ks * 64 + fq * 16);
                    sa = __builtin_amdgcn_mfma_f32_16x16x32_bf16(a, bb, sa, 0, 0, 0); } }
            const int si = ts * 16 + fr; const float rs = sb[si];
#pragma unroll
            for (int rg = 0; rg < 4; ++rg) { const int ti = tt * 16 + 4 * fq + rg; const float pw = sa[rg] * __expf(rs - sb[64 + ti]);
                *(LAS unsigned short*)(L + PS + ti * TST + si * 2) = (unsigned short)f2bf(si <= ti ? pw : 0.f); } } }
        LBAR();
        { const int t = tid >> 3, part = tid & 7; const u32x4 pp = *(const LAS u32x4*)(L + PS + t * TST + part * 16); float d1 = 0.f, d2 = 0.f;
#pragma unroll
          for (int e = 0; e < 4; ++e) d1 += bf_lo(pp[e]) + bf_hi(pp[e]);
#pragma unroll
          for (int i = 0; i < 2; ++i) { const u32x4 qq = *(const LAS u32x4*)(L + QS + t * QST + part * 32 + i * 16);
#pragma unroll
            for (int e = 0; e < 4; ++e) { const f32x2 nv = *(const LAS f32x2*)(L + NV + (part * 16 + i * 8 + 2 * e) * 4); d2 += bf_lo(qq[e]) * nv[0] + bf_hi(qq[e]) * nv[1]; } }
          d1 += __shfl_xor(d1, 1); d1 += __shfl_xor(d1, 2); d1 += __shfl_xor(d1, 4); d2 += __shfl_xor(d2, 1); d2 += __shfl_xor(d2, 2); d2 += __shfl_xor(d2, 4);
          const float den = d1 + sb[128 + t] * d2;
          if (part == 0) sb[384 + t] = __builtin_amdgcn_rcpf(fmaxf(fabsf(den), sb[192 + t])); }
        f32x4 n1[4], nI[4]; bf16x8 vf[2];
#pragma unroll
        for (int ks = 0; ks < 2; ++ks) vf[ks] = TRFRAG2(VS, WST, w, ks);
#pragma unroll
        for (int t4 = 0; t4 < 4; ++t4) { n1[t4] = (f32x4){0.f, 0.f, 0.f, 0.f}; nI[t4] = (f32x4){0.f, 0.f, 0.f, 0.f};
#pragma unroll
            for (int ks = 0; ks < 2; ++ks) if (ks * 32 <= t4 * 16 + 15) { const bf16x8 a = *(const LAS bf16x8*)(L + PS + (t4 * 16 + fr) * TST + ks * 64 + fq * 16); n1[t4] = __builtin_amdgcn_mfma_f32_16x16x32_bf16(a, vf[ks], n1[t4], 0, 0, 0); } }
        { bf16x8 cf[4];
#pragma unroll
          for (int ks = 0; ks < 4; ++ks) cf[ks] = *(const LAS bf16x8*)(L + CB + (w * 16 + fr) * QST + ks * 64 + fq * 16);
#pragma unroll
          for (int t4 = 0; t4 < 4; ++t4)
#pragma unroll
            for (int ks = 0; ks < 4; ++ks) { const bf16x8 a = *(const LAS bf16x8*)(L + QS + (t4 * 16 + fr) * QST + ks * 64 + fq * 16); nI[t4] = __builtin_amdgcn_mfma_f32_16x16x32_bf16(a, cf[ks], nI[t4], 0, 0, 0); } }
        LBAR();
#pragma unroll
        for (int t4 = 0; t4 < 4; ++t4)
#pragma unroll
            for (int rg = 0; rg < 4; ++rg) { const int ti = t4 * 16 + 4 * fq + rg; ((LAS float*)(L + HS))[ti * HST + w * 16 + fr] = n1[t4][rg] + sb[128 + ti] * nI[t4][rg]; }
        LBAR();
        { const int t = tid >> 3, part = tid & 7; const float dinv = sb[384 + t]; float x[16]; float sm = 0.f;
#pragma unroll
          for (int i = 0; i < 4; ++i) { const f32x4 hv = *(const LAS f32x4*)(L + HS + (t * HST + part * 16 + i * 4) * 4);
#pragma unroll
            for (int e = 0; e < 4; ++e) { x[i * 4 + e] = hv[e] * dinv; sm += x[i * 4 + e]; } }
          sm += __shfl_xor(sm, 1); sm += __shfl_xor(sm, 2); sm += __shfl_xor(sm, 4);
          const float mean = sm * (1.0f / 128.0f); float qv = 0.f;
#pragma unroll
          for (int j = 0; j < 16; ++j) { x[j] -= mean; qv += x[j] * x[j]; }
          qv += __shfl_xor(qv, 1); qv += __shfl_xor(qv, 2); qv += __shfl_xor(qv, 4);
          const float rstd = __builtin_amdgcn_rsqf(qv * (1.0f / 128.0f) + LN_EPS);
          gin wn = F.in(I_MHW) + l * 512 + h * 128 + part * 16;
          float rr[16];
#pragma unroll
          for (int e = 0; e < 4; ++e) { rr[2 * e] = bf_lo(ro[0][e]); rr[2 * e + 1] = bf_hi(ro[0][e]); rr[8 + 2 * e] = bf_lo(ro[1][e]); rr[8 + 2 * e + 1] = bf_hi(ro[1][e]); }
#pragma unroll
          for (int j = 0; j < 16; ++j) rr[j] = x[j] * rstd * wn[j] * __builtin_amdgcn_rcpf(1.0f + __expf(-rr[j]));
          u32x4 w0, w1;
#pragma unroll
          for (int e = 0; e < 4; ++e) { w0[e] = pg8::cvt_pk_bf16(rr[2 * e], rr[2 * e + 1]); w1[e] = pg8::cvt_pk_bf16(rr[8 + 2 * e], rr[8 + 2 * e + 1]); }
          bf16* dp2 = outp + (size_t)(tok0 + t) * D + h * 128 + part * 16; *(u32x4*)dp2 = w0; *(u32x4*)(dp2 + 8) = w1; }
        ro[0] = ro2[0]; ro[1] = ro2[1];
        LBAR();
        if (!more) break;
        cid = nxt;
    }
#undef MLO_FETCH
}
__device__ __forceinline__ void conv_items(Frame& F, int l, int first_block, int nblocks) {
    const bf16* proj = (const bf16*)(F.ws + WS_BIG); bf16* outp = (bf16*)(F.ws + WS_UA);
    const int nthreads = nblocks * NTHR;
    for (int id = (F.bid - first_block) * NTHR + F.tid; id < (T / 32) * 64; id += nthreads) {
        const int cg = id & 63, run = id >> 6, t0 = run * 32, c0 = cg * 8;
        float w[3][8];
#pragma unroll
        for (int j = 0; j < 3; ++j)
#pragma unroll
            for (int e = 0; e < 8; ++e) w[j][e] = F.in(I_WCONV)[(size_t)l * 3 * 512 + j * 512 + c0 + e];
        float z1[8], z2[8];
#pragma unroll
        for (int e = 0; e < 8; ++e) { z1[e] = 0.f; z2[e] = 0.f; }
        if ((t0 & (SEQ - 1)) != 0) {
#pragma unroll
            for (int back = 1; back <= 2; ++back) { const bf16* p = proj + (size_t)(t0 - back) * DINW + 2560 + c0; const u32x4 cc = *(const u32x4*)p, ch = *(const u32x4*)(p + 512);
#pragma unroll
                for (int e = 0; e < 4; ++e) { const float a = bf_lo(cc[e]) * bf_lo(ch[e]), b2 = bf_hi(cc[e]) * bf_hi(ch[e]); if (back == 1) { z1[2 * e] = a; z1[2 * e + 1] = b2; } else { z2[2 * e] = a; z2[2 * e + 1] = b2; } } }
        }
        for (int t = t0; t < t0 + 32; ++t) { const bf16* p = proj + (size_t)t * DINW + 2048 + c0; const u32x4 cb = *(const u32x4*)p, cc = *(const u32x4*)(p + 512), ch = *(const u32x4*)(p + 1024);
            float z0[8], y[8];
#pragma unroll
            for (int e = 0; e < 4; ++e) { z0[2 * e] = bf_lo(cc[e]) * bf_lo(ch[e]); z0[2 * e + 1] = bf_hi(cc[e]) * bf_hi(ch[e]); }
#pragma unroll
            for (int e = 0; e < 4; ++e) { y[2 * e] = bf_lo(cb[e]) * (w[0][2 * e] * z2[2 * e] + w[1][2 * e] * z1[2 * e] + w[2][2 * e] * z0[2 * e]);
                y[2 * e + 1] = bf_hi(cb[e]) * (w[0][2 * e + 1] * z2[2 * e + 1] + w[1][2 * e + 1] * z1[2 * e + 1] + w[2][2 * e + 1] * z0[2 * e + 1]); }
            u32x4 o;
#pragma unroll
            for (int e = 0; e < 4; ++e) o[e] = pk2(y[2 * e], y[2 * e + 1]);
            *(u32x4*)(outp + (size_t)t * D + 512 + c0) = o;
#pragma unroll
            for (int e = 0; e < 8; ++e) { z2[e] = z1[e]; z1[e] = z0[e]; } }
    }
}
__device__ __forceinline__ void phase_mix1(Frame& F, int l) {
    rebind(F);
    if (F.G >= 256) { if (F.bid < 128) mlstm_state_unit(F, l, F.bid); else conv_items(F, l, 128, F.G - 128); }
    else { for (int u = F.bid; u < 128; u += F.G) mlstm_state_unit(F, l, u); conv_items(F, l, 0, F.G); }
}
__device__ __forceinline__ void phase_mix2(Frame& F, int l) { rebind(F); mlstm_out_phase(F, l); }
__device__ __forceinline__ void phase_mixer(Frame& F, int l) {
    rebind(F);
    const int nm = F.G > 64 ? 64 : 0;
#ifdef MIXER_NAIVE
    if (nm) { if (F.bid < 64) mlstm_naive_unit(F, l, F.bid); else conv_items(F, l, 64, F.G - 64); }
    else { for (int u = F.bid; u < 64; u += F.G) mlstm_naive_unit(F, l, u); conv_items(F, l, 0, F.G); }
#else
    if (nm) { if (F.bid < 64) mlstm_chunk_unit(F, l, F.bid); else conv_items(F, l, 64, F.G - 64); }
    else { for (int u = F.bid; u < 64; u += F.G) { mlstm_chunk_unit(F, l, u); __syncthreads(); } conv_items(F, l, 0, F.G); }
#endif
}

__device__ __forceinline__ int moe_tables(Frame& F, int l) {
    LAS int* tcls = (LAS int*)(F.lds + MISC_OFF + MO_TCLS); LAS int* ttb = (LAS int*)(F.lds + MISC_OFF + MO_TTB); LAS int* cnts = (LAS int*)(F.lds + MISC_OFF + MO_CNT); LAS int* ntp = (LAS int*)(F.lds + MISC_OFF + MO_NT);
    __syncthreads();
    if (F.tid == 0) { int t = 0;
        for (int c = 0; c < NCLS; ++c) { int n = (int)__hip_atomic_load(F.ctl + CW_CNT + l * 32 + c, RLX_AGENT); if (n > CLS_CAP) n = CLS_CAP; cnts[c] = n;
            for (int j = 0; j * 256 < n && t < MAXTILES; ++j) { tcls[t] = c; ttb[t] = j * 256; ++t; } }
        ntp[0] = t; }
    __syncthreads();
    return ntp[0];
}
__device__ __forceinline__ void phase_moe_gu(Frame& F, int l) {
    rebind(F);
    const int NT = moe_tables(F, l);
    PolMoeGU P; P.tcls = (const LAS int*)(F.lds + MISC_OFF + MO_TCLS); P.ttb = (const LAS int*)(F.lds + MISC_OFF + MO_TTB); P.cnts = (const LAS int*)(F.lds + MISC_OFF + MO_CNT);
    P.NT = NT; P.G = F.G; P.c = F.bid; P.A = (const char*)(F.ws + WS_UA); P.B = (const char*)(F.ws + WS_WGU) + (size_t)l * 16 * 1024 * 2048; P.ri = (const RInfo*)(F.ws + WS_RINFO); P.H = (bf16*)(F.ws + WS_BIG);
    pg8::gemm_phase<PolMoeGU, true>(F.lds, P);
}
__device__ __forceinline__ void phase_moe_down(Frame& F, int l) {
    rebind(F);
    const int NT = moe_tables(F, l);
    PolMoeDown P; P.tcls = (const LAS int*)(F.lds + MISC_OFF + MO_TCLS); P.ttb = (const LAS int*)(F.lds + MISC_OFF + MO_TTB); P.cnts = (const LAS int*)(F.lds + MISC_OFF + MO_CNT);
    P.NT = NT; P.G = F.G; P.c = F.bid; P.A = (const char*)(F.ws + WS_BIG); P.B = (const char*)(F.ws + WS_WD) + (size_t)l * 16 * 1024 * 1024; P.ri = (const RInfo*)(F.ws + WS_RINFO); P.Y = (bf16*)(F.ws + WS_Y);
    pg8::gemm_phase<PolMoeDown, true>(F.lds, P);
}
__device__ __forceinline__ void phase_inproj(Frame& F, int l) {
    rebind(F);
    PolInProj P; P.so.init(T, DINW, F.G, F.bid); P.A = (const char*)(F.ws + WS_UA); P.B = (const char*)(F.ws + WS_WIN) + (size_t)l * DINW * 2048; P.O = (bf16*)(F.ws + WS_BIG);
    pg8::gemm_phase<PolInProj, true>(F.lds, P);
}
__device__ __forceinline__ void phase_outproj(Frame& F, int l) {
    rebind(F);
    PolOutProj P; P.so.init(T, D, F.G, F.bid); P.A = (const char*)(F.ws + WS_UA); P.B = (const char*)(F.ws + WS_WOUT) + (size_t)l * D * 2048; P.C = (bf16*)(F.ws + WS_BIG);
    pg8::gemm_phase<PolOutProj, true>(F.lds, P);
}

#include <cstdlib>
#include <vector>

#define XB_TMO      128
#define XB_XCNT(j)  (256  + 64 * (j))
#define XB_XSUB(j)  (1280 + 64 * (j))
#define XB_XGEN(j)  (2304 + 64 * (j))
#define XB_TOP      3328
#define XB_TOPGEN   3392
#define XCD_BAR_WORDS 3456
#define XB_SPIN_CAP (1u << 18)

__device__ __forceinline__ unsigned xb_ld(unsigned* p)              { return __hip_atomic_load(p, __ATOMIC_RELAXED, __HIP_MEMORY_SCOPE_AGENT); }
__device__ __forceinline__ unsigned xb_add(unsigned* p, unsigned v) { return __hip_atomic_fetch_add(p, v, __ATOMIC_RELAXED, __HIP_MEMORY_SCOPE_AGENT); }
__device__ __forceinline__ unsigned xb_xcc_id() { return (unsigned)__builtin_amdgcn_s_getreg((3 << 11) | 20) & 0xFu; }
#define XB_SPIN(cond, bar) do { unsigned _sp = 0; while (cond) { __builtin_amdgcn_s_sleep(1); \
    if ((++_sp & 255u) == 0u) { if (xb_ld(&(bar)[XB_TMO])) break; if (_sp > XB_SPIN_CAP) { atomicAdd(&(bar)[XB_TMO], 1u); break; } } } } while (0)

struct XcdBarrier {
    unsigned* bar; unsigned x;
    volatile LAS unsigned* st;
};

__device__ __forceinline__ XcdBarrier xcd_barrier_post(unsigned* bar, volatile LAS unsigned* st) {
    XcdBarrier b; b.bar = bar; b.x = xb_xcc_id(); b.st = st;
    if (threadIdx.x == 0) (void)xb_add(&bar[XB_XCNT(b.x)], 1u);
    return b;
}
__device__ __forceinline__ void xcd_barrier_complete(unsigned* bar, unsigned x, unsigned& nloc, unsigned& nx) {
    const unsigned G = gridDim.x * gridDim.y * gridDim.z;
    unsigned sum, cnt, mine, sp = 0u;
    for (;;) {
        sum = 0u; cnt = 0u; mine = 0u;
#pragma unroll
        for (unsigned j = 0; j < 16; ++j) { const unsigned c = xb_ld(&bar[XB_XCNT(j)]); sum += c; cnt += (c > 0u) ? 1u : 0u; mine = (j == x) ? c : mine; }
        if (sum == G) break;
        __builtin_amdgcn_s_sleep(1);
        if ((++sp & 255u) == 0u) { if (xb_ld(&bar[XB_TMO])) break; if (sp > XB_SPIN_CAP) { atomicAdd(&bar[XB_TMO], 1u); break; } }
    }
    nloc = mine > 0u ? mine : 1u; nx = cnt > 0u ? cnt : 1u;
}

__device__ __forceinline__ void xcd_barrier(const XcdBarrier& b) {
    asm volatile("s_waitcnt vmcnt(0)" ::: "memory");
    __syncthreads();
    if (threadIdx.x == 0) {
        unsigned* bar = b.bar;
        __builtin_amdgcn_s_waitcnt(0);
        unsigned nloc = b.st[0], nx = b.st[1];
        if (nloc == 0u) { xcd_barrier_complete(bar, b.x, nloc, nx); b.st[0] = nloc; b.st[1] = nx; }
        const unsigned old = xb_add(&bar[XB_XSUB(b.x)], 1u);
        const unsigned gen = old / nloc;
        if (old + 1u == (gen + 1u) * nloc) {
            __builtin_amdgcn_fence(__ATOMIC_RELEASE, "agent");
            asm volatile("s_waitcnt vmcnt(0)" ::: "memory");
            const unsigned og = xb_add(&bar[XB_TOP], 1u);
            const unsigned tg = og / nx;
            if (og + 1u == (tg + 1u) * nx) xb_add(&bar[XB_TOPGEN], 1u);
            else XB_SPIN(xb_ld(&bar[XB_TOPGEN]) == tg, bar);
            __builtin_amdgcn_fence(__ATOMIC_ACQUIRE, "agent");
            xb_add(&bar[XB_XGEN(b.x)], 1u);
            asm volatile("s_waitcnt vmcnt(0)" ::: "memory");
        } else {
            XB_SPIN(xb_ld(&bar[XB_XGEN(b.x)]) == gen, bar);
            __builtin_amdgcn_fence(__ATOMIC_ACQUIRE, "agent");
            asm volatile("s_waitcnt vmcnt(0)" ::: "memory");
        }
    }
    __syncthreads();
}

enum { PH_PRO = 0, PH_ROWA, PH_INPROJ, PH_MIXER, PH_OUTPROJ, PH_ROWB, PH_MOEGU, PH_MOEDOWN, PH_ROWC };
#ifndef MK_N_LAUNCHES
#define MK_N_LAUNCHES 1
#endif
__device__ __forceinline__ void frame_init(Frame& F, const Args& args, unsigned char* lds) {
    F.lds = (LAS unsigned char*)lds; F.ws = F.ws0 = args.ws; F.ctl = (gu32*)(args.ws + WS_CTL); F.out = F.out0 = args.out;
    F.ap = (KArgs)__builtin_amdgcn_kernarg_segment_ptr();
    F.tid = threadIdx.x; F.lane = F.tid & 63; F.wave = __builtin_amdgcn_readfirstlane(F.tid >> 6); F.G = gridDim.x;
}
#if MK_N_LAUNCHES == 1
__global__ void __launch_bounds__(NTHR, 2) fwd(Args args) {
    extern __shared__ __attribute__((aligned(16))) unsigned char lds[];
    Frame F; frame_init(F, args, lds);
    for (int u = F.tid; u < (LDS_BYTES - MISC_OFF) / 4; u += NTHR) ((LAS unsigned*)(F.lds + MISC_OFF))[u] = 0u;
    __syncthreads();
    const XcdBarrier bar = xcd_barrier_post((unsigned*)(args.ws + WS_CTL) + CW_BAR, (volatile LAS unsigned*)(F.lds + MISC_OFF + MO_BAR));
#define GRID_BAR() do { XcdBarrier bb_ = bar; size_t zo_ = 0; asm volatile("" : "+s"(zo_), "+s"(bb_.x)); bb_.bar = bar.bar + zo_; xcd_barrier(bb_); } while (0)
    phase_prologue(F); GRID_BAR();
    phase_rowA(F); GRID_BAR();
    static_assert(NL == 2, "two layers written out (no runtime layer loop: nothing to hoist out of it)");
#define LAYER(l, LASTL) do { phase_inproj(F, l); GRID_BAR(); phase_mix1(F, l); GRID_BAR(); phase_mix2(F, l); GRID_BAR(); phase_outproj(F, l); GRID_BAR(); phase_rowB(F, l); GRID_BAR(); \
        phase_moe_gu(F, l); GRID_BAR(); phase_moe_down(F, l); GRID_BAR(); phase_rowC(F, l); if (!(LASTL)) GRID_BAR(); } while (0)
    LAYER(0, false);
    LAYER(1, true);
#undef LAYER
}
#else
template <int PH>
__global__ void __launch_bounds__(NTHR, 2) k_phase(Args args) {
    extern __shared__ __attribute__((aligned(16))) unsigned char lds[];
    Frame F; frame_init(F, args, lds);
    const int l = args.l;
    if constexpr (PH == PH_PRO) phase_prologue(F);
    if constexpr (PH == PH_ROWA) phase_rowA(F);
    if constexpr (PH == PH_INPROJ) phase_inproj(F, l);
    if constexpr (PH == PH_MIXER) phase_mixer(F, l);
    if constexpr (PH == PH_OUTPROJ) phase_outproj(F, l);
    if constexpr (PH == PH_ROWB) phase_rowB(F, l);
    if constexpr (PH == PH_MOEGU) phase_moe_gu(F, l);
    if constexpr (PH == PH_MOEDOWN) phase_moe_down(F, l);
    if constexpr (PH == PH_ROWC) phase_rowC(F, l);
}
template <int PH> static bool launch_phase(const Args& a, int grid, hipStream_t stream) {
    static bool attr = false;
    if (!attr) { if (hipFuncSetAttribute((const void*)k_phase<PH>, hipFuncAttributeMaxDynamicSharedMemorySize, LDS_BYTES) != hipSuccess) { fprintf(stderr, "kernel_launch: hipFuncSetAttribute failed (phase %d)\n", PH); return false; } attr = true; }
    hipLaunchKernelGGL(k_phase<PH>, dim3(grid), dim3(NTHR), LDS_BYTES, stream, a);
    const hipError_t le = hipPeekAtLastError();
    if (le != hipSuccess) { fprintf(stderr, "kernel_launch: launch of phase %d failed: %s\n", PH, hipGetErrorName(le)); return false; }
    return true;
}
#endif

extern "C" void kernel_launch(void* const* d_in, const int* in_sizes, int n_in, void* d_out, int out_size, void* d_ws, size_t ws_size, hipStream_t stream) {
    static int grid = 0;
    if (grid == 0) {
        if (n_in != 20 || in_sizes[0] != T * D || out_size != T * D || ws_size < WS_END) { fprintf(stderr, "kernel_launch: unexpected shapes (n_in %d, in0 %d, out %d, ws %zu < %zu)\n", n_in, n_in > 0 ? in_sizes[0] : -1, out_size, ws_size, (size_t)WS_END); grid = -1; return; }
        int dev = 0, cus = 0;
        if (hipGetDevice(&dev) != hipSuccess || hipDeviceGetAttribute(&cus, hipDeviceAttributeMultiprocessorCount, dev) != hipSuccess) { grid = -1; return; }
#if MK_N_LAUNCHES == 1
        if (hipFuncSetAttribute((const void*)fwd, hipFuncAttributeMaxDynamicSharedMemorySize, LDS_BYTES) != hipSuccess) { fprintf(stderr, "kernel_launch: hipFuncSetAttribute failed\n"); grid = -1; return; }
        int per_cu = 0;
        if (hipOccupancyMaxActiveBlocksPerMultiprocessor(&per_cu, (const void*)fwd, NTHR, LDS_BYTES) != hipSuccess || per_cu < 1) { fprintf(stderr, "kernel_launch: occupancy query reports %d workgroups per CU; nothing launched\n", per_cu); grid = -1; return; }
        (void)hipGetLastError();
#endif
        grid = cus;
    }
    if (grid < 0) return;
    if (hipMemsetAsync((char*)d_ws + WS_CTL, 0, CTL_ZERO_BYTES, stream) != hipSuccess) return;
    Args a{};
    for (int i = 0; i < 20; ++i) a.in[i] = (const float*)d_in[i];
    a.out = (float*)d_out; a.ws = (unsigned char*)d_ws; a.l = 0; a.pad = 0;
#if MK_N_LAUNCHES == 1
    hipLaunchKernelGGL(fwd, dim3(grid), dim3(NTHR), LDS_BYTES, stream, a);
    const hipError_t le = hipPeekAtLastError();
    if (le != hipSuccess) fprintf(stderr, "kernel_launch: launch failed: %s\n", hipGetErrorName(le));
#else
#define LP(PH) do { if (!launch_phase<PH>(a, grid, stream)) return; } while (0)
    LP(PH_PRO);
    LP(PH_ROWA);
    for (int l = 0; l < NL; ++l) {
        a.l = l;
        LP(PH_INPROJ); LP(PH_MIXER); LP(PH_OUTPROJ); LP(PH_ROWB); LP(PH_MOEGU); LP(PH_MOEDOWN); LP(PH_ROWC);
    }
#endif
}
```
